# Optimizing an MI355X kernel written in HIP

```python
import math
import jax
import jax.numpy as jnp
from jax import lax
import numpy as np

D_MODEL = 1024
BATCH = 2
SEQ = 16384
DEPTH = 4

HY_WIDTH = 512
HY_ORDER = 2
HY_SHORT = 3
HY_EMB = 33
HY_BANDS = (HY_EMB - 1) // 2
HY_FILTER_HIDDEN = 64
HY_INNER_MLPS = 2
HY_FAST_DECAY = 0.3
HY_SLOW_DECAY = 1.5
HY_DECAY_TARGET = 1e-2

SW_HEADS = 8
SW_KV_HEADS = 2
SW_HEAD_DIM = 64
SW_WINDOW = 128
SW_BLOCK = 128
ROPE_THETA = 500000.0
ROPE_DIM = SW_HEAD_DIM // 4

MEM_TOKENS = 256
MEM_HEADS = 4
MEM_HEAD_DIM = 128

N_BRANCH = 3

N_EXPERTS = 32
TOP_K = 4
D_EXPERT = D_MODEL
SWIGLU_ALPHA = 1.702
SWIGLU_LIMIT = 7.0
MOE_BLOCK = 256

LN_EPS = 1e-5
NEG_INF = -1e30
DEEPNORM_ALPHA = (2 * DEPTH) ** 0.25
DEEPNORM_BETA = (8 * DEPTH) ** -0.25

HY_COLS = 3 * HY_WIDTH
Q_COLS = SW_HEADS * SW_HEAD_DIM
KV_COLS = SW_KV_HEADS * SW_HEAD_DIM
MQ_COLS = MEM_HEADS * MEM_HEAD_DIM
GATE_COLS = N_BRANCH * D_MODEL
IN_COLS = HY_COLS + Q_COLS + 2 * KV_COLS + MQ_COLS + GATE_COLS
IN_SPLITS = (HY_COLS, HY_COLS + Q_COLS, HY_COLS + Q_COLS + KV_COLS,
             HY_COLS + Q_COLS + 2 * KV_COLS, HY_COLS + Q_COLS + 2 * KV_COLS + MQ_COLS)

kernel_name = 'hybrid_hyena_swa_memory_moe_encoder'


def layer_norm(x, g, b):
    xf = x.astype(jnp.float32)
    mu = jnp.mean(xf, axis=-1, keepdims=True)
    var = jnp.mean(jnp.square(xf - mu), axis=-1, keepdims=True)
    y = (xf - mu) * lax.rsqrt(var + LN_EPS)
    return (y * g.astype(jnp.float32) + b.astype(jnp.float32)).astype(x.dtype)


def short_conv(z, w, b):
    L = z.shape[1]
    r = HY_SHORT // 2
    zp = jnp.pad(z, ((0, 0), (r, r), (0, 0)))
    out = zp[:, 0:L] * w[0] + b
    for j in range(1, HY_SHORT):
        out = out + zp[:, j:j + L] * w[j]
    return out


def hyena_filters(L, f1_w, f1_b, f2_w, f2_b, f3_w, freq):
    f32 = jnp.float32
    t01 = jnp.linspace(0.0, 1.0, L, dtype=f32)[:, None]
    w = (2.0 * math.pi) * jnp.arange(L, dtype=f32)[:, None] / L
    bands = jnp.linspace(1e-4, HY_BANDS - 1, HY_BANDS, dtype=f32)
    z = jnp.concatenate([t01, jnp.cos(bands * w), -jnp.sin(bands * w)], axis=-1)
    fr = freq.astype(f32)
    h = jnp.sin(fr * (z @ f1_w.astype(f32) + f1_b.astype(f32)))
    for i in range(HY_INNER_MLPS):
        h = jnp.sin(fr * (h @ f2_w[i].astype(f32) + f2_b[i].astype(f32)))
    h = (h @ f3_w.astype(f32)).reshape(L, HY_ORDER, 2, HY_WIDTH)
    max_decay = math.log(HY_DECAY_TARGET) / HY_FAST_DECAY
    min_decay = math.log(HY_DECAY_TARGET) / HY_SLOW_DECAY
    deltas = jnp.linspace(min_decay, max_decay, HY_WIDTH, dtype=f32)
    window = jnp.exp(-t01 * jnp.abs(deltas))
    h = h * window[:, None, None, :]
    h_fwd, h_bwd = h[:, :, 0], h[:, :, 1]
    k = jnp.concatenate([h_fwd, jnp.zeros_like(h_fwd[:1]), h_bwd[1:][::-1]], axis=0)
    return jnp.fft.rfft(k, axis=0)


def bidir_fftconv(u, k_f, skip):
    L = u.shape[1]
    uf = jnp.fft.rfft(u.astype(jnp.float32), n=2 * L, axis=1)
    y = jnp.fft.irfft(uf * k_f[None], n=2 * L, axis=1)[:, :L]
    return (y + u.astype(jnp.float32) * skip.astype(jnp.float32)).astype(u.dtype)


def partial_rope(x, pos):
    half = ROPE_DIM // 2
    inv = jnp.power(jnp.float32(ROPE_THETA), -jnp.arange(half, dtype=jnp.float32) * (2.0 / ROPE_DIM))
    ang = pos.astype(jnp.float32)[:, None] * inv
    cos = jnp.cos(ang)[None, :, None, :]
    sin = jnp.sin(ang)[None, :, None, :]
    xf = x.astype(jnp.float32)
    x1, x2 = xf[..., :half], xf[..., half:ROPE_DIM]
    out = jnp.concatenate([x1 * cos - x2 * sin, x2 * cos + x1 * sin, xf[..., ROPE_DIM:]], axis=-1)
    return out.astype(x.dtype)


def banded_sink_attention(q, k, v, sink):
    B, S, _, hd = q.shape
    nb = S // SW_BLOCK
    G = SW_HEADS // SW_KV_HEADS
    qb = q.reshape(B, nb, SW_BLOCK, SW_KV_HEADS, G, hd)

    def windows(t):
        tp = jnp.pad(t, ((0, 0), (SW_BLOCK, SW_BLOCK), (0, 0), (0, 0)))
        tp = tp.reshape(B, nb + 2, SW_BLOCK, SW_KV_HEADS, hd)
        return jnp.concatenate([tp[:, :-2], tp[:, 1:-1], tp[:, 2:]], axis=2)

    kw, vw = windows(k), windows(v)
    s = jnp.einsum('bnqhgd,bnkhd->bnhgqk', qb, kw, preferred_element_type=jnp.float32) * (hd ** -0.5)
    blk = jnp.arange(nb)[:, None, None]
    qpos = blk * SW_BLOCK + jnp.arange(SW_BLOCK)[None, :, None]
    kpos = (blk - 1) * SW_BLOCK + jnp.arange(3 * SW_BLOCK)[None, None, :]
    valid = (jnp.abs(qpos - kpos) <= SW_WINDOW) & (kpos >= 0) & (kpos < S)
    s = jnp.where(valid[None, :, None, None], s, NEG_INF)
    sk = sink.astype(jnp.float32).reshape(1, 1, SW_KV_HEADS, G, 1, 1)
    m = jnp.maximum(jnp.max(s, axis=-1, keepdims=True), sk)
    p = jnp.exp(s - m)
    denom = jnp.sum(p, axis=-1, keepdims=True) + jnp.exp(sk - m)
    o = jnp.einsum('bnhgqk,bnkhd->bnqhgd', (p / denom).astype(v.dtype), vw)
    return o.reshape(B, S, SW_HEADS * hd)


def memory_attention(q, mk, mv):
    B, S, H, hd = q.shape
    s = jnp.einsum('bshd,bmhd->bhsm', q, mk, preferred_element_type=jnp.float32) * (hd ** -0.5)
    p = jax.nn.softmax(s, axis=-1).astype(mv.dtype)
    o = jnp.einsum('bhsm,bmhd->bshd', p, mv)
    return o.reshape(B, S, H * hd)


def clamped_swiglu(h):
    h_glu, h_lin = h[..., ::2], h[..., 1::2]
    h_glu = jnp.minimum(h_glu, SWIGLU_LIMIT)
    h_lin = jnp.clip(h_lin, -SWIGLU_LIMIT, SWIGLU_LIMIT)
    return h_glu * jax.nn.sigmoid(SWIGLU_ALPHA * h_glu) * (h_lin + 1.0)


def moe_ffn(x2, router_w, router_b, w1, b1, w2, b2):
    N, D = x2.shape
    logits = (x2 @ router_w + router_b).astype(jnp.float32)
    top_v, top_i = lax.top_k(logits, TOP_K)
    gate = jax.nn.softmax(top_v, axis=-1)
    A = N * TOP_K
    n_blocks = -(-(A + N_EXPERTS * (MOE_BLOCK - 1)) // MOE_BLOCK)
    P = n_blocks * MOE_BLOCK
    e_flat = top_i.reshape(-1).astype(jnp.int32)
    order = jnp.argsort(e_flat)
    e_sorted = e_flat[order]
    tok_sorted = (order // TOP_K).astype(jnp.int32)
    w_sorted = gate.reshape(-1)[order].astype(x2.dtype)
    counts = jnp.bincount(e_flat, length=N_EXPERTS)
    padded = (counts + MOE_BLOCK - 1) // MOE_BLOCK * MOE_BLOCK
    pad_end = jnp.cumsum(padded)
    start = jnp.cumsum(counts) - counts
    dest = pad_end[e_sorted] - padded[e_sorted] + jnp.arange(A, dtype=jnp.int32) - start[e_sorted]
    slot_tok = jnp.full((P,), N, jnp.int32).at[dest].set(tok_sorted)
    slot_w = jnp.zeros((P,), x2.dtype).at[dest].set(w_sorted)
    block_expert = jnp.minimum(
        jnp.searchsorted(pad_end, jnp.arange(n_blocks, dtype=pad_end.dtype) * MOE_BLOCK, side='right'),
        N_EXPERTS - 1)
    x_pad = jnp.concatenate([x2, jnp.zeros((1, D), x2.dtype)], axis=0)

    def expert_block(args):
        tok, wt, e = args
        h = x_pad[tok] @ w1[e] + b1[e]
        y = clamped_swiglu(h) @ w2[e] + b2[e]
        return y * wt[:, None]

    ys = lax.map(expert_block, (slot_tok.reshape(n_blocks, MOE_BLOCK),
                                slot_w.reshape(n_blocks, MOE_BLOCK), block_expert))
    out = jax.ops.segment_sum(ys.reshape(P, D), slot_tok, num_segments=N + 1)
    return out[:N]


def mixer_block(x, mem, pos, w_in, b_gate, hy_conv_w, hy_conv_b, hy_f1_w, hy_f1_b, hy_f2_w, hy_f2_b,
                hy_f3_w, hy_freq, hy_skip, sw_sink, mem_w_kv, w_br_hy, w_br_swa, w_br_mem, w_out):
    B, S, D = x.shape
    proj = x @ w_in
    z_hy, q, k, v, mq, gl = jnp.split(proj, IN_SPLITS, axis=-1)

    z_hy = short_conv(z_hy, hy_conv_w, hy_conv_b)
    hv, hx1, hx2 = jnp.split(z_hy, 3, axis=-1)
    kf = hyena_filters(S, hy_f1_w, hy_f1_b, hy_f2_w, hy_f2_b, hy_f3_w, hy_freq)
    y_hy = hv
    for o, gx in enumerate((hx1, hx2)):
        y_hy = gx * bidir_fftconv(y_hy, kf[:, o], hy_skip[o])

    q = partial_rope(q.reshape(B, S, SW_HEADS, SW_HEAD_DIM), pos)
    k = partial_rope(k.reshape(B, S, SW_KV_HEADS, SW_HEAD_DIM), pos)
    v = v.reshape(B, S, SW_KV_HEADS, SW_HEAD_DIM)
    y_sw = banded_sink_attention(q, k, v, sw_sink)

    M = mem.shape[1]
    mk, mv = jnp.split(mem @ mem_w_kv, 2, axis=-1)
    y_mem = memory_attention(mq.reshape(B, S, MEM_HEADS, MEM_HEAD_DIM),
                             mk.reshape(B, M, MEM_HEADS, MEM_HEAD_DIM),
                             mv.reshape(B, M, MEM_HEADS, MEM_HEAD_DIM))

    g = jax.nn.sigmoid(gl.reshape(B, S, N_BRANCH, D) + b_gate)
    merged = (g[:, :, 0] * (y_hy @ w_br_hy) + g[:, :, 1] * (y_sw @ w_br_swa)
              + g[:, :, 2] * (y_mem @ w_br_mem))
    return merged @ w_out


def setup_inputs(seed: int = 0) -> dict:
    key = jax.random.key(seed)
    ks = iter(jax.random.split(key, 32))

    def nrm(shape, scale):
        return jax.random.normal(next(ks), shape, jnp.float32) * scale

    D, L = D_MODEL, DEPTH
    return {
        'x': nrm((BATCH, SEQ, D), 1.0),
        'mem': nrm((BATCH, MEM_TOKENS, D), 1.0),
        'ln_in_g': 1.0 + nrm((D,), 0.02),
        'ln_in_b': nrm((D,), 0.02),
        'w_in': nrm((L, D, IN_COLS), D ** -0.5),
        'b_gate': nrm((L, N_BRANCH, D), 0.1),
        'hy_conv_w': nrm((L, HY_SHORT, HY_COLS), HY_SHORT ** -0.5),
        'hy_conv_b': nrm((L, HY_COLS), 0.02),
        'hy_f1_w': nrm((L, HY_EMB, HY_FILTER_HIDDEN), HY_EMB ** -0.5),
        'hy_f1_b': nrm((L, HY_FILTER_HIDDEN), 0.5),
        'hy_f2_w': nrm((L, HY_INNER_MLPS, HY_FILTER_HIDDEN, HY_FILTER_HIDDEN), HY_FILTER_HIDDEN ** -0.5),
        'hy_f2_b': nrm((L, HY_INNER_MLPS, HY_FILTER_HIDDEN), 0.5),
        'hy_f3_w': nrm((L, HY_FILTER_HIDDEN, HY_ORDER * 2 * HY_WIDTH), 0.02 * HY_FILTER_HIDDEN ** -0.5),
        'hy_freq': 1.0 + nrm((L, HY_FILTER_HIDDEN), 0.02),
        'hy_skip': nrm((L, HY_ORDER, HY_WIDTH), 0.5),
        'sw_sink': nrm((L, SW_HEADS), 0.5),
        'mem_w_kv': nrm((L, D, 2 * MQ_COLS), D ** -0.5),
        'w_br_hy': nrm((L, HY_WIDTH, D), HY_WIDTH ** -0.5),
        'w_br_swa': nrm((L, Q_COLS, D), Q_COLS ** -0.5),
        'w_br_mem': nrm((L, MQ_COLS, D), MQ_COLS ** -0.5),
        'w_out': nrm((L, D, D), DEEPNORM_BETA * D ** -0.5),
        'ln1_g': 1.0 + nrm((L, D), 0.02),
        'ln1_b': nrm((L, D), 0.02),
        'router_w': nrm((L, D, N_EXPERTS), D ** -0.5),
        'router_b': nrm((L, N_EXPERTS), 0.01),
        'moe_w1': nrm((L, N_EXPERTS, D, 2 * D_EXPERT), D ** -0.5),
        'moe_b1': nrm((L, N_EXPERTS, 2 * D_EXPERT), 0.01),
        'moe_w2': nrm((L, N_EXPERTS, D_EXPERT, D), DEEPNORM_BETA * D_EXPERT ** -0.5),
        'moe_b2': nrm((L, N_EXPERTS, D), 0.01),
        'ln2_g': 1.0 + nrm((L, D), 0.02),
        'ln2_b': nrm((L, D), 0.02),
    }


def reference(x, mem, ln_in_g, ln_in_b, w_in, b_gate, hy_conv_w, hy_conv_b, hy_f1_w, hy_f1_b,
              hy_f2_w, hy_f2_b, hy_f3_w, hy_freq, hy_skip, sw_sink, mem_w_kv, w_br_hy, w_br_swa,
              w_br_mem, w_out, ln1_g, ln1_b, router_w, router_b, moe_w1, moe_b1, moe_w2, moe_b2,
              ln2_g, ln2_b):
    B, S, D = x.shape
    pos = jnp.arange(S, dtype=jnp.int32)
    x = layer_norm(x, ln_in_g, ln_in_b)
    for l in range(DEPTH):
        h = mixer_block(x, mem, pos, w_in[l], b_gate[l], hy_conv_w[l], hy_conv_b[l], hy_f1_w[l],
                        hy_f1_b[l], hy_f2_w[l], hy_f2_b[l], hy_f3_w[l], hy_freq[l], hy_skip[l],
                        sw_sink[l], mem_w_kv[l], w_br_hy[l], w_br_swa[l], w_br_mem[l], w_out[l])
        x = layer_norm(DEEPNORM_ALPHA * x + h, ln1_g[l], ln1_b[l])
        f = moe_ffn(x.reshape(B * S, D), router_w[l], router_b[l], moe_w1[l], moe_b1[l],
                    moe_w2[l], moe_b2[l]).reshape(B, S, D)
        x = layer_norm(DEEPNORM_ALPHA * x + f, ln2_g[l], ln2_b[l])
    return x
```

```cpp
#include <hip/hip_runtime.h>
#include <cstdio>
#include <cstdint>

#ifndef MK_PER_PHASE
#define MK_PER_PHASE 0
#endif

#ifndef PH_MASK
#define PH_MASK 0xFFFFFFFFu
#endif
#define EN(b) ((PH_MASK >> (b)) & 1u)
#ifndef DUP_MASK
#define DUP_MASK 0u
#endif
#define REP(b) for (int rep_ = 0; rep_ < (((DUP_MASK >> (b)) & 1u) ? 2 : 1); ++rep_)
#define REPBAR() do { if (rep_) { GRIDBAR(); } } while (0)
#define DI __device__ __forceinline__
#define LAS __attribute__((address_space(3)))
#define GAS __attribute__((address_space(1)))
typedef unsigned short bf16_t;
typedef short bf16x8 __attribute__((ext_vector_type(8)));
typedef short s16x4 __attribute__((ext_vector_type(4)));
typedef float f32x2 __attribute__((ext_vector_type(2)));
typedef float f32x4 __attribute__((ext_vector_type(4)));
typedef float f32x16 __attribute__((ext_vector_type(16)));
typedef unsigned u32x2 __attribute__((ext_vector_type(2)));
typedef unsigned u32x4 __attribute__((ext_vector_type(4)));
typedef __bf16 bf16v2 __attribute__((ext_vector_type(2)));

DI unsigned pk2(float lo, float hi) { f32x2 v = {lo, hi}; return __builtin_bit_cast(unsigned, __builtin_convertvector(v, bf16v2)); }
DI float bflo(unsigned w) { return __uint_as_float(w << 16); }
DI float bfhi(unsigned w) { return __uint_as_float(w & 0xffff0000u); }
typedef _Float16 h16x2 __attribute__((ext_vector_type(2)));
DI unsigned pkh(float a, float b) { f32x2 v = {a, b}; return __builtin_bit_cast(unsigned, __builtin_convertvector(v, h16x2)); }
DI f32x2 unh(unsigned w) { return __builtin_convertvector(__builtin_bit_cast(h16x2, w), f32x2); }
typedef int v8i __attribute__((ext_vector_type(8)));
DI float clamp8(float x) { return __builtin_amdgcn_fmed3f(x, -448.0f, 448.0f); }
DI unsigned pk4f8(float a, float b, float c, float d) { a = clamp8(a); b = clamp8(b); c = clamp8(c); d = clamp8(d); int w = 0; w = __builtin_amdgcn_cvt_pk_fp8_f32(a, b, w, false); w = __builtin_amdgcn_cvt_pk_fp8_f32(c, d, w, true); return (unsigned)w; }
DI float bf1(float x) { return bflo(pk2(x, 0.f) & 0xffffu); }

constexpr int NTOK = 32768, DM = 1024, SEQ = 16384, NBATCH = 2, DEPTH = 4;
constexpr int INC = 5888;
constexpr int PJ = 4352, C_Q = 0, C_K = 512, C_V = 640, C_MQ = 768, C_GL = 1280;
constexpr int NEXP = 32, MAXTILES = 544, PMAX = MAXTILES * 256;
constexpr int NCHUNK = 256, CHUNK = 128;
constexpr float LN_EPS = 1e-5f, ALPHA = 1.681792830507429f;
constexpr int NPH_LAYER = 11, NPHASES = 2 + DEPTH * NPH_LAYER;

constexpr size_t MiB = 1u << 20;
constexpr size_t WS_CTL = 0, CTL_ZERO_BYTES = 1 * MiB;
constexpr size_t WS_ROUTE = 1 * MiB;
constexpr size_t RT_E = 0, RT_G = 512 * 1024, RT_POS = 1024 * 1024, RT_BLKCNT = 1536 * 1024, RT_SLOT = 1600 * 1024, RT_TILE = 2200 * 1024, RT_NT = 2208 * 1024, RT_IOTA = 2304 * 1024;
constexpr size_t WS_X8 = (134 + 256) * MiB, WS_WG8 = (134 + 256 + 32) * MiB;
constexpr size_t WS_ROPE = 51 * MiB;
constexpr size_t WS_MEMB = 5 * MiB, WS_MK = 6 * MiB, WS_MVT = 10 * MiB, WS_FH = 14 * MiB, WS_FW = 46 * MiB, WS_RW = 50 * MiB;
constexpr size_t WS_WIN = 52 * MiB, WS_WKV = 98 * MiB, WS_WBR = 114 * MiB, WS_WOUT = 126 * MiB, WS_W1 = 134 * MiB, WS_W2 = 646 * MiB;
constexpr size_t WS_HF = 902 * MiB, WS_XB = 1414 * MiB, WS_PROJ = 1478 * MiB, WS_ZT = 1750 * MiB, WS_ZC = 1846 * MiB, WS_Y2 = 2038 * MiB;
constexpr size_t WS_YHY = 2102 * MiB, WS_YSW = 2134 * MiB, WS_YMEM = 2166 * MiB, WS_MERGED = 2198 * MiB, WS_R = 2262 * MiB;
constexpr size_t WS_X1 = 2390 * MiB, WS_X1B = 2518 * MiB, WS_ACT = 2582 * MiB, WS_YBUF = 2854 * MiB, WS_FFTS = 3126 * MiB, WS_END = 3318 * MiB;
constexpr int CW_BAR = 4096;

constexpr int SCR_BYTES = 139264;
constexpr int MISC_OFF = SCR_BYTES;
constexpr int LDS_BYTES = 147456;

#define XB_TMO      128
#define XB_XCNT(j)  (256  + 64 * (j))
#define XB_XSUB(j)  (1280 + 64 * (j))
#define XB_XGEN(j)  (2304 + 64 * (j))
#define XB_TOP      3328
#define XB_TOPGEN   3392
#define XCD_BAR_WORDS 3456
#define XB_SPIN_CAP (1u << 18)
__device__ __forceinline__ unsigned xb_ld(unsigned* p)              { return __hip_atomic_load(p, __ATOMIC_RELAXED, __HIP_MEMORY_SCOPE_AGENT); }
__device__ __forceinline__ unsigned xb_add(unsigned* p, unsigned v) { return __hip_atomic_fetch_add(p, v, __ATOMIC_RELAXED, __HIP_MEMORY_SCOPE_AGENT); }
__device__ __forceinline__ unsigned xb_xcc_id() { return (unsigned)__builtin_amdgcn_s_getreg((3 << 11) | 20) & 0xFu; }
#define XB_SPIN(cond, bar) do { unsigned _sp = 0; while (cond) { __builtin_amdgcn_s_sleep(1); \
    if ((++_sp & 255u) == 0u) { if (xb_ld(&(bar)[XB_TMO])) break; if (_sp > XB_SPIN_CAP) { atomicAdd(&(bar)[XB_TMO], 1u); break; } } } } while (0)
struct XcdBarrier { unsigned* bar; unsigned x; volatile LAS unsigned* st; };
__device__ __forceinline__ XcdBarrier xcd_barrier_post(unsigned* bar, volatile LAS unsigned* st) {
    XcdBarrier b; b.bar = bar; b.x = xb_xcc_id(); b.st = st;
    if (threadIdx.x == 0) (void)xb_add(&bar[XB_XCNT(b.x)], 1u);
    return b;
}
__device__ __forceinline__ void xcd_barrier_complete(unsigned* bar, unsigned x, unsigned& nloc, unsigned& nx) {
    const unsigned G = gridDim.x * gridDim.y * gridDim.z;
    unsigned sum, cnt, mine, sp = 0u;
    for (;;) {
        sum = 0u; cnt = 0u; mine = 0u;
#pragma unroll
        for (unsigned j = 0; j < 16; ++j) { const unsigned c = xb_ld(&bar[XB_XCNT(j)]); sum += c; cnt += (c > 0u) ? 1u : 0u; mine = (j == x) ? c : mine; }
        if (sum == G) break;
        __builtin_amdgcn_s_sleep(1);
        if ((++sp & 255u) == 0u) { if (xb_ld(&bar[XB_TMO])) break; if (sp > XB_SPIN_CAP) { atomicAdd(&bar[XB_TMO], 1u); break; } }
    }
    nloc = mine > 0u ? mine : 1u; nx = cnt > 0u ? cnt : 1u;
}
__device__ __forceinline__ void xcd_barrier(const XcdBarrier& b) {
    asm volatile("s_waitcnt vmcnt(0)" ::: "memory");
    __syncthreads();
    if (threadIdx.x == 0) {
        unsigned* bar = b.bar;
        __builtin_amdgcn_s_waitcnt(0);
        unsigned nloc = b.st[0], nx = b.st[1];
        if (nloc == 0u) { xcd_barrier_complete(bar, b.x, nloc, nx); b.st[0] = nloc; b.st[1] = nx; }
        const unsigned old = xb_add(&bar[XB_XSUB(b.x)], 1u);
        const unsigned gen = old / nloc;
        if (old + 1u == (gen + 1u) * nloc) {
            __builtin_amdgcn_fence(__ATOMIC_RELEASE, "agent");
            asm volatile("s_waitcnt vmcnt(0)" ::: "memory");
            const unsigned og = xb_add(&bar[XB_TOP], 1u);
            const unsigned tg = og / nx;
            if (og + 1u == (tg + 1u) * nx) xb_add(&bar[XB_TOPGEN], 1u);
            else XB_SPIN(xb_ld(&bar[XB_TOPGEN]) == tg, bar);
            __builtin_amdgcn_fence(__ATOMIC_ACQUIRE, "agent");
            xb_add(&bar[XB_XGEN(b.x)], 1u);
            asm volatile("s_waitcnt vmcnt(0)" ::: "memory");
        } else {
            XB_SPIN(xb_ld(&bar[XB_XGEN(b.x)]) == gen, bar);
            __builtin_amdgcn_fence(__ATOMIC_ACQUIRE, "agent");
            asm volatile("s_waitcnt vmcnt(0)" ::: "memory");
        }
    }
    __syncthreads();
}

namespace pg8 {
constexpr int BM = 256, BK = 64, HALF = 128, HTB = HALF * BK * 2, STAGE_BYTES = 8 * HTB, NXCD = 8, WGM = 8;
DI int lds_byte(int r, int c) { const int st = (r >> 4) * 2 + (c >> 5), rr = r & 15, cc = c & 31, ob = rr * 64 + cc * 2; return st * 1024 + (ob ^ (((ob >> 9) & 1) << 5)); }
DI void stage_rc(int b, int& R, int& C) { const int st = b / 1024, sb = b % 1024, swz = sb ^ (((sb >> 9) & 1) << 5); R = (st >> 1) * 16 + swz / 64; C = (st & 1) * 32 + (swz % 64) / 2; }
DI int perm32(int rho) { const int n = rho >> 4, i = rho & 15; return 8 * (i >> 2) + 4 * n + (i & 3); }

struct Unit { int am, bm, om, on, e; };
struct Gemm { const bf16_t* A; const bf16_t* Bt; int K; const int* gather; LAS unsigned char* aux = nullptr; const float* pbias = nullptr; int pbstride = 0; };

struct TileOrder {
    int nM, nN, nwg, G, c;
    DI void init(int nM_, int nN_, int G_, int c_) { nM = nM_; nN = nN_; nwg = nM * nN; G = G_; c = c_; }
    DI bool tile(int i, int& pm, int& pn) const {
        const long L = (long)i * G + c; if (L >= nwg) return false;
        int wgid = (int)L; { const int q = nwg / NXCD, r = nwg % NXCD, xcd = wgid % NXCD, off = wgid / NXCD; wgid = (xcd < r ? xcd * (q + 1) : r * (q + 1) + (xcd - r) * q) + off; }
        const int nig = WGM * nN, gid = wgid / nig, fm = gid * WGM, gsz = (nM - fm) < WGM ? (nM - fm) : WGM;
        pm = fm + ((wgid % nig) % gsz); pn = (wgid % nig) / gsz; return true;
    }
};
struct StaticOrder : TileOrder { DI bool next(int i, Unit& u) const { int pm, pn; if (!tile(i, pm, pn)) return false; u.am = pm; u.bm = pn; u.om = pm; u.on = pn; u.e = 0; return true; } };
struct GroupOrder : TileOrder { const int* tile_e;
    DI bool next(int i, Unit& u) const { int pm, pn; if (!tile(i, pm, pn)) return false; const int e = __builtin_amdgcn_readfirstlane(tile_e[pm]); u.am = pm; u.bm = e * nN + pn; u.om = pm; u.on = pn; u.e = e; return true; } };
struct GroupOrderL : TileOrder { const LAS int* tile_e;
    DI bool next(int i, Unit& u) const { int pm, pn; if (!tile(i, pm, pn)) return false; const int e = __builtin_amdgcn_readfirstlane(tile_e[pm]); u.am = pm; u.bm = e * nN + pn; u.om = pm; u.on = pn; u.e = e; return true; } };
struct BatchOrder { int nL, nM, nN, amL, am0, bmL, bm0, G, c;
    DI bool next(int i, Unit& u) const { const int L = i * G + c; if (L >= nL * nM * nN) return false; const int l = L / (nM * nN), r = L % (nM * nN), pm = r % nM, pn = r / nM;
        u.am = l * amL + am0 + pm; u.bm = l * bmL + bm0 + pn; u.om = pm; u.on = pn; u.e = l; return true; } };

struct EpiBf16 {
    static constexpr bool PERM = true;
    bf16_t* O; int ldc; size_t estride; const float* bias; int bstride; float scale = 1.0f; int f8out = 0;
    DI void operator()(const f32x4 (&acc)[2][2][4][2], const Unit& u, int wr, int wc, int fr, int fq, const LAS float* lb = nullptr) const {
        const int row0 = u.om * BM + wr * 64 + fr, col0 = u.on * BM + wc * 32 + 8 * fq; bf16_t* base = O + (size_t)u.e * estride;
        f32x4 bv[2][2];
#pragma unroll
        for (int bj = 0; bj < 2; ++bj)
#pragma unroll
            for (int n = 0; n < 2; ++n) bv[bj][n] = lb ? *(const LAS f32x4*)(lb + wc * 32 + 8 * fq + bj * HALF + 4 * n) : (bias ? *(const f32x4*)(bias + (size_t)u.e * bstride + col0 + bj * HALF + 4 * n) : (f32x4){0.f, 0.f, 0.f, 0.f});
#pragma unroll
        for (int ai = 0; ai < 2; ++ai)
#pragma unroll
            for (int m = 0; m < 4; ++m) { bf16_t* rowp = base + (size_t)(row0 + ai * HALF + m * 16) * ldc + col0;
#pragma unroll
                for (int bj = 0; bj < 2; ++bj) { const f32x4 v0 = acc[ai][bj][m][0] * scale + bv[bj][0], v1 = acc[ai][bj][m][1] * scale + bv[bj][1];
                    if (f8out) { u32x2 w8; w8.x = pk4f8(v0[0] * 64.0f, v0[1] * 64.0f, v0[2] * 64.0f, v0[3] * 64.0f); w8.y = pk4f8(v1[0] * 64.0f, v1[1] * 64.0f, v1[2] * 64.0f, v1[3] * 64.0f);
                        *(u32x2*)((unsigned char*)base + (size_t)(row0 + ai * HALF + m * 16) * ldc + col0 + bj * HALF) = w8; }
                    else { u32x4 w; w.x = pk2(v0[0], v0[1]); w.y = pk2(v0[2], v0[3]); w.z = pk2(v1[0], v1[1]); w.w = pk2(v1[2], v1[3]);
                        *(u32x4*)(rowp + bj * HALF) = w; } } }
    }
};
struct EpiWin {
    static constexpr bool PERM = false;
    _Float16* O;
    DI void operator()(const f32x4 (&acc)[2][2][4][2], const Unit& u, int wr, int wc, int fr, int fq) const {
        const int row0 = u.om * BM + wr * 64 + fr, col0 = u.on * BM + wc * 32 + 4 * fq; _Float16* base = O + (size_t)u.e * 2048 * SEQ;
#pragma unroll
        for (int ai = 0; ai < 2; ++ai)
#pragma unroll
            for (int m = 0; m < 4; ++m) { _Float16* rowp = base + (size_t)(row0 + ai * HALF + m * 16) * SEQ + col0;
#pragma unroll
                for (int bj = 0; bj < 2; ++bj)
#pragma unroll
                    for (int n = 0; n < 2; ++n) { const f32x4 v = acc[ai][bj][m][n] * 256.0f; u32x2 w; w.x = pkh(v[0], v[1]); w.y = pkh(v[2], v[3]); *(u32x2*)(rowp + bj * HALF + n * 16) = w; } }
    }
};
struct EpiRes {
    static constexpr bool PERM = true;
    const bf16_t* X; bf16_t* R;
    DI void operator()(const f32x4 (&acc)[2][2][4][2], const Unit& u, int wr, int wc, int fr, int fq) const {
        const int row0 = u.om * BM + wr * 64 + fr, col0 = u.on * BM + wc * 32 + 8 * fq;
#pragma unroll
        for (int ai = 0; ai < 2; ++ai)
#pragma unroll
            for (int m = 0; m < 4; ++m) { const size_t off = (size_t)(row0 + ai * HALF + m * 16) * DM + col0;
#pragma unroll
                for (int bj = 0; bj < 2; ++bj) { const u32x4 xv = *(const u32x4*)(X + off + bj * HALF); const f32x4 a0 = acc[ai][bj][m][0], a1 = acc[ai][bj][m][1];
                    u32x4 w; w.x = pk2(bflo(xv.x) * ALPHA + a0[0], bfhi(xv.x) * ALPHA + a0[1]); w.y = pk2(bflo(xv.y) * ALPHA + a0[2], bfhi(xv.y) * ALPHA + a0[3]);
                    w.z = pk2(bflo(xv.z) * ALPHA + a1[0], bfhi(xv.z) * ALPHA + a1[1]); w.w = pk2(bflo(xv.w) * ALPHA + a1[2], bfhi(xv.w) * ALPHA + a1[3]);
                    *(u32x4*)(R + off + bj * HALF) = w; } }
    }
};
struct EpiGate {
    static constexpr bool PERM = true;
    const unsigned char* gl0; const float* bg0; bf16_t* O;
    DI void operator()(const f32x4 (&acc)[2][2][4][2], const Unit& u, int wr, int wc, int fr, int fq) const {
        const int row0 = u.om * BM + wr * 64 + fr, col0 = u.on * BM + wc * 32 + 8 * fq; const unsigned char* gl = gl0 + u.e * 1024; const float* bg = bg0 + u.e * 1024; const bool first = (u.e == 0);
        f32x4 bv[2][2];
#pragma unroll
        for (int bj = 0; bj < 2; ++bj)
#pragma unroll
            for (int n = 0; n < 2; ++n) bv[bj][n] = *(const f32x4*)(bg + col0 + bj * HALF + 4 * n);
#pragma unroll
        for (int ai = 0; ai < 2; ++ai)
#pragma unroll
            for (int m = 0; m < 4; ++m) { const int row = row0 + ai * HALF + m * 16;
#pragma unroll
                for (int bj = 0; bj < 2; ++bj) { const int col = col0 + bj * HALF;
                    const u32x2 gw = *(const u32x2*)(gl + (size_t)row * 3072 + col);
                    u32x4 old = {0u, 0u, 0u, 0u}; if (!first) old = *(const u32x4*)(O + (size_t)row * DM + col);
                    float r[8];
#pragma unroll
                    for (int j = 0; j < 4; ++j) { const unsigned o2 = old[j]; const f32x2 g2 = (j & 1) ? __builtin_amdgcn_cvt_pk_f32_fp8((int)gw[j >> 1], true) : __builtin_amdgcn_cvt_pk_f32_fp8((int)gw[j >> 1], false);
                        const float a0 = g2.x * (1.0f / 16.0f) + bv[bj][j >> 1][(j & 1) * 2], a1 = g2.y * (1.0f / 16.0f) + bv[bj][j >> 1][(j & 1) * 2 + 1];
                        const float s0 = __builtin_amdgcn_rcpf(1.0f + __builtin_amdgcn_exp2f(-1.4426950408889634f * a0)), s1 = __builtin_amdgcn_rcpf(1.0f + __builtin_amdgcn_exp2f(-1.4426950408889634f * a1));
                        r[2 * j] = bflo(o2) + s0 * acc[ai][bj][m][j >> 1][(j & 1) * 2]; r[2 * j + 1] = bfhi(o2) + s1 * acc[ai][bj][m][j >> 1][(j & 1) * 2 + 1]; }
                    u32x4 w; w.x = pk2(r[0], r[1]); w.y = pk2(r[2], r[3]); w.z = pk2(r[4], r[5]); w.w = pk2(r[6], r[7]);
                    *(u32x4*)(O + (size_t)row * DM + col) = w; } }
    }
};
struct EpiSwiglu {
    static constexpr bool PERM = true;
    unsigned char* O; const float* bias; float ascale;
    DI void operator()(const f32x4 (&acc)[2][2][4][2], const Unit& u, int wr, int wc, int fr, int fq, const LAS float* lb = nullptr) const {
        const int row0 = u.om * BM + wr * 64 + fr, col0 = u.on * BM + wc * 32 + 8 * fq;
        f32x4 bv[2][2];
#pragma unroll
        for (int bj = 0; bj < 2; ++bj)
#pragma unroll
            for (int n = 0; n < 2; ++n) bv[bj][n] = lb ? *(const LAS f32x4*)(lb + wc * 32 + 8 * fq + bj * HALF + 4 * n) : *(const f32x4*)(bias + (size_t)u.e * 2048 + col0 + bj * HALF + 4 * n);
#pragma unroll
        for (int ai = 0; ai < 2; ++ai)
#pragma unroll
            for (int m = 0; m < 4; ++m) { unsigned char* rowp = O + (size_t)(row0 + ai * HALF + m * 16) * DM + (col0 >> 1);
#pragma unroll
                for (int bj = 0; bj < 2; ++bj) { const f32x4 v0 = acc[ai][bj][m][0] * ascale + bv[bj][0], v1 = acc[ai][bj][m][1] * ascale + bv[bj][1];
                    float o[4];
#pragma unroll
                    for (int j = 0; j < 4; ++j) { float gl_ = (j < 2) ? v0[2 * j] : v1[2 * j - 4], ln_ = (j < 2) ? v0[2 * j + 1] : v1[2 * j - 3];
                        gl_ = fminf(gl_, 7.0f); ln_ = fminf(fmaxf(ln_, -7.0f), 7.0f);
                        o[j] = 8.0f * gl_ * __builtin_amdgcn_rcpf(1.0f + __builtin_amdgcn_exp2f(-1.702f * 1.4426950408889634f * gl_)) * (ln_ + 1.0f); }
                    *(unsigned*)(rowp + bj * (HALF / 2)) = pk4f8(o[0], o[1], o[2], o[3]); } }
    }
};
struct BranchOrder : TileOrder { int l;
    DI bool next(int i, Unit& u) const { int pm, pn; const int t = i / 3, br = i - 3 * t; if (!tile(t, pm, pn)) return false; u.am = br * 128 + pm; u.bm = (br * 4 + l) * 4 + pn; u.om = pm; u.on = pn; u.e = br; return true; } };
struct InOrder { TileOrder T; int G, c, l, tA, tW;
    DI bool next(int i, Unit& u) const { const int L = i * G + c; if (L >= 1408) return false;
        if (L < 640) { int pm, pn; T.tile(i, pm, pn); u.am = tA + pm; u.bm = tW + l * 23 + 6 + pn; u.om = pm; u.on = pn; u.e = 1; }
        else { const int r = L - 640, pw = r % 6, pt = r / 6; u.am = tW + l * 23 + pw; u.bm = tA + pt; u.om = pw; u.on = pt; u.e = 0; }
        return true; } };
struct GateOrder : TileOrder { int l, tA, tW;
    DI bool next(int i, Unit& u) const { int pm, pn; if (!tile(i, pm, pn)) return false; u.am = tA + pm; u.bm = tW + l * 12 + pn; u.om = pm; u.on = 5 + pn; u.e = 1; return true; } };
struct EpiGL8 {
    static constexpr bool PERM = true;
    unsigned char* O; float scale;
    DI void operator()(const f32x4 (&acc)[2][2][4][2], const Unit& u, int wr, int wc, int fr, int fq) const {
        const int row0 = u.om * BM + wr * 64 + fr, col0 = (u.on - 5) * BM + wc * 32 + 8 * fq;
#pragma unroll
        for (int ai = 0; ai < 2; ++ai)
#pragma unroll
            for (int m = 0; m < 4; ++m) { unsigned char* rowp = O + (size_t)(row0 + ai * HALF + m * 16) * 3072 + col0;
#pragma unroll
                for (int bj = 0; bj < 2; ++bj) { const f32x4 v0 = acc[ai][bj][m][0] * scale, v1 = acc[ai][bj][m][1] * scale;
                    u32x2 w; w.x = pk4f8(v0[0], v0[1], v0[2], v0[3]); w.y = pk4f8(v1[0], v1[1], v1[2], v1[3]); *(u32x2*)(rowp + bj * HALF) = w; } }
    }
};
struct EpiIn {
    static constexpr bool PERM = true;
    bf16_t* P; bf16_t* Z; float scale;
    DI void operator()(const f32x4 (&acc)[2][2][4][2], const Unit& u, int wr, int wc, int fr, int fq) const {
        const int row0 = u.om * BM + wr * 64 + fr, col0 = u.on * BM + wc * 32 + 8 * fq; bf16_t* base = u.e ? P : Z; const int ldc = u.e ? PJ : NTOK;
#pragma unroll
        for (int ai = 0; ai < 2; ++ai)
#pragma unroll
            for (int m = 0; m < 4; ++m) { bf16_t* rowp = base + (size_t)(row0 + ai * HALF + m * 16) * ldc + col0;
#pragma unroll
                for (int bj = 0; bj < 2; ++bj) { const f32x4 v0 = acc[ai][bj][m][0] * scale, v1 = acc[ai][bj][m][1] * scale;
                    u32x4 w; w.x = pk2(v0[0], v0[1]); w.y = pk2(v0[2], v0[3]); w.z = pk2(v1[0], v1[1]); w.w = pk2(v1[2], v1[3]);
                    *(u32x4*)(rowp + bj * HALF) = w; } }
    }
};
template <class Epi, class Sched, bool GATHER, bool FP8 = false, bool PREF = false>
DI void gemm_phase(LAS unsigned char* lds, const Gemm g, const Sched& S, const Epi& E, int wave_id) {
    unsigned z_o = 0u; asm volatile("" : "+v"(z_o));
    int tid_o = wave_id * 64 + (int)__builtin_amdgcn_mbcnt_hi(~0u, __builtin_amdgcn_mbcnt_lo(~0u, z_o)); asm volatile("" : "+v"(tid_o));
    const int tid = tid_o, wid = __builtin_amdgcn_readfirstlane(tid >> 6), lane = tid & 63, wr = wid >> 2, wc = wid & 3, fr = lane & 15, fq = lane >> 4;
    const int K = g.K, RB = FP8 ? K : 2 * K, nt = RB / 128;
    unsigned voffA[2], voffB[2];
#pragma unroll
    for (int i = 0; i < 2; ++i) { int R, C; stage_rc(tid * 16 + i * 8192, R, C); const int Rb = Epi::PERM ? ((R & ~31) + perm32(R & 31)) : R;
        voffA[i] = (unsigned)(R * RB + 2 * C); voffB[i] = (unsigned)(Rb * RB + 2 * C); }
    const size_t kstep = (size_t)(BK * 2);
    const size_t hstep = (size_t)HALF * RB;
    const size_t tstep = 2 * hstep;
    const unsigned ldsw = (unsigned)wid * 1024u;
    const int aoff = lds_byte(wr * 64 + fr, fq * 8), boff = lds_byte(wc * 32 + fr, fq * 8);
#define PG8_SA(b, h) (((b) * 2 + (h)) * HTB)
#define PG8_SB(b, h) ((4 + (b) * 2 + (h)) * HTB)
#define PG8_STAGE(bufoff, gbase, voff) do { _Pragma("unroll") for (int _i = 0; _i < 2; ++_i) \
        __builtin_amdgcn_global_load_lds((const unsigned*)((const char*)(gbase) + (voff)[_i]), (LAS unsigned*)(lds + (bufoff) + ldsw + _i * 8192), 16, 0, 0); } while (0)
#define PG8_STAGE_A(bufoff, kb, h, vg) do { if constexpr (GATHER) { PG8_STAGE(bufoff, kb, (vg)[h]); } else { PG8_STAGE(bufoff, (kb) + (h) * hstep, voffA); } } while (0)
#define PG8_LDA(dst, b, h) do { if constexpr (FP8) { _Pragma("unroll") for (int m = 0; m < 4; ++m) dst##8[m] = PG8_LD8(lds + PG8_SA(b, h) + aoff + m * 2048); } \
        else { _Pragma("unroll") for (int m = 0; m < 4; ++m) _Pragma("unroll") for (int k = 0; k < 2; ++k) dst[m][k] = *(const LAS bf16x8*)(lds + PG8_SA(b, h) + aoff + m * 2048 + k * 1024); } } while (0)
#define PG8_LDB(dst, b, h) do { if constexpr (FP8) { _Pragma("unroll") for (int n = 0; n < 2; ++n) dst##8[n] = PG8_LD8(lds + PG8_SB(b, h) + boff + n * 2048); } \
        else { _Pragma("unroll") for (int n = 0; n < 2; ++n) _Pragma("unroll") for (int k = 0; k < 2; ++k) dst[n][k] = *(const LAS bf16x8*)(lds + PG8_SB(b, h) + boff + n * 2048 + k * 1024); } } while (0)
#define PG8_LD8(p) __builtin_shufflevector(*(const LAS u32x4*)(p), *(const LAS u32x4*)((p) + 1024), 0, 1, 2, 3, 4, 5, 6, 7)
#define PG8_MMA(ai, bj, At, Bt) do { __builtin_amdgcn_s_setprio(1); _Pragma("unroll") for (int m = 0; m < 4; ++m) _Pragma("unroll") for (int n = 0; n < 2; ++n) { \
        if constexpr (FP8) acc[ai][bj][m][n] = __builtin_amdgcn_mfma_scale_f32_16x16x128_f8f6f4(__builtin_bit_cast(v8i, Bt##8[n]), __builtin_bit_cast(v8i, At##8[m]), acc[ai][bj][m][n], 0, 0, 0, 0x7F7F7F7F, 0, 0x7F7F7F7F); \
        else { _Pragma("unroll") for (int k = 0; k < 2; ++k) acc[ai][bj][m][n] = __builtin_amdgcn_mfma_f32_16x16x32_bf16(Bt[n][k], At[m][k], acc[ai][bj][m][n], 0, 0, 0); } } \
        __builtin_amdgcn_s_setprio(0); } while (0)
#define PG8_WAIT_V(n) asm volatile("s_waitcnt vmcnt(" #n ")" ::: "memory")
#define PG8_WAIT_L(n) asm volatile("s_waitcnt lgkmcnt(" #n ")" ::: "memory")
#define PG8_BAR __builtin_amdgcn_s_barrier()
#define PG8_SCHED __builtin_amdgcn_sched_barrier(0)
#define PG8_GATHER(vg, unit) do { _Pragma("unroll") for (int _i = 0; _i < 2; ++_i) { int _R, _C; stage_rc(tid * 16 + _i * 8192, _R, _C); _Pragma("unroll") for (int _h = 0; _h < 2; ++_h) \
        { const int _row = (unit).am * BM + _h * HALF + _R; (vg)[_h][_i] = (unsigned)(g.gather ? g.gather[_row] : _row) * (unsigned)RB + (unsigned)_C * 2u; } } } while (0)
#define PG8_PREF(unit, par) do { if (wid < 4) __builtin_amdgcn_global_load_lds((const unsigned*)(g.gather + (unit).am * BM + wid * 64 + lane), (LAS unsigned*)(g.aux + (par) * 1024 + wid * 256), 4, 0, 0); \
        else __builtin_amdgcn_global_load_lds((const unsigned*)(g.pbias + (size_t)(unit).e * g.pbstride + (unit).on * BM + (wid - 4) * 64 + lane), (LAS unsigned*)(g.aux + 2048 + (par) * 1024 + (wid - 4) * 256), 4, 0, 0); } while (0)
#define PG8_VG_LDS(vg, par) do { _Pragma("unroll") for (int _i = 0; _i < 2; ++_i) { int _R, _C; stage_rc(tid * 16 + _i * 8192, _R, _C); _Pragma("unroll") for (int _h = 0; _h < 2; ++_h) \
        (vg)[_h][_i] = (unsigned)((const LAS int*)(g.aux + (par) * 1024))[_h * HALF + _R] * (unsigned)RB + (unsigned)_C * 2u; } } while (0)
    Unit cur, nxt; int ui = 0;
    if (!S.next(0, cur)) return;
    f32x4 acc[2][2][4][2];
#pragma unroll
    for (int a = 0; a < 2; ++a)
#pragma unroll
        for (int b = 0; b < 2; ++b)
#pragma unroll
            for (int m = 0; m < 4; ++m)
#pragma unroll
                for (int n = 0; n < 2; ++n) acc[a][b][m][n] = (f32x4){0.f, 0.f, 0.f, 0.f};
    bf16x8 At[4][2], B0[2][2], B1[2][2];
    typedef unsigned u32x8 __attribute__((ext_vector_type(8)));
    u32x8 At8[4], B08[2], B18[2];
    unsigned vG[2][2] = {{0u, 0u}, {0u, 0u}}, vGn[2][2] = {{0u, 0u}, {0u, 0u}};
    const char* cA = (const char*)g.A + (GATHER ? (size_t)0 : (size_t)cur.am * tstep); const char* cB = (const char*)g.Bt + (size_t)cur.bm * tstep;
    if constexpr (PREF) { PG8_PREF(cur, 0); asm volatile("s_waitcnt vmcnt(0)" ::: "memory"); __builtin_amdgcn_s_barrier(); asm volatile("" ::: "memory"); PG8_VG_LDS(vG, 0); }
    else if constexpr (GATHER) { PG8_GATHER(vG, cur); }
    PG8_STAGE(PG8_SB(0, 0), cB, voffB); PG8_STAGE(PG8_SB(0, 1), cB + hstep, voffB); PG8_STAGE_A(PG8_SA(0, 0), cA, 0, vG); PG8_STAGE_A(PG8_SA(0, 1), cA, 1, vG);
    if (wr == 1) PG8_BAR;
    PG8_WAIT_V(2); PG8_BAR;
    PG8_STAGE(PG8_SB(1, 0), cB + kstep, voffB); PG8_STAGE_A(PG8_SA(1, 0), cA + kstep, 0, vG); PG8_STAGE(PG8_SB(1, 1), cB + hstep + kstep, voffB);
    PG8_WAIT_V(6); PG8_BAR;
    for (;;) {
        const bool has_next = S.next(ui + 1, nxt);
        const char* nA = has_next ? (const char*)g.A + (GATHER ? (size_t)0 : (size_t)nxt.am * tstep) : cA; const char* nB = has_next ? (const char*)g.Bt + (size_t)nxt.bm * tstep : cB;
        if constexpr (PREF) { if (has_next) PG8_PREF(nxt, (ui + 1) & 1); }
        else if constexpr (GATHER) { if (has_next) { PG8_GATHER(vGn, nxt); } else {
#pragma unroll
            for (int _h = 0; _h < 2; ++_h)
#pragma unroll
                for (int _i = 0; _i < 2; ++_i) vGn[_h][_i] = vG[_h][_i]; } }
#pragma unroll 1
        for (int t = 0; t < nt; t += 2) {
            const bool last = (t == nt - 2);
            const char* a1 = cA + (size_t)(t + 1) * kstep;
            const char* a2 = last ? nA : cA + (size_t)(t + 2) * kstep; const char* b2 = last ? nB : cB + (size_t)(t + 2) * kstep;
            const char* a3 = a2 + kstep; const char* b3 = b2 + kstep;
            PG8_LDB(B0, 0, 0); PG8_LDB(B1, 0, 1); PG8_SCHED; PG8_LDA(At, 0, 0); PG8_STAGE_A(PG8_SA(1, 1), a1, 1, vG);
            if constexpr (PREF) { if (last && has_next) { PG8_VG_LDS(vG, (ui + 1) & 1); } }
            else if constexpr (GATHER) { if (last) {
#pragma unroll
                for (int _h = 0; _h < 2; ++_h)
#pragma unroll
                    for (int _i = 0; _i < 2; ++_i) vG[_h][_i] = vGn[_h][_i]; } }
            PG8_WAIT_V(8); PG8_WAIT_L(0); PG8_BAR; PG8_MMA(0, 0, At, B0); PG8_MMA(0, 1, At, B1); PG8_BAR; PG8_SCHED;
            PG8_LDA(At, 0, 1); PG8_STAGE(PG8_SB(0, 0), b2, voffB); PG8_STAGE(PG8_SB(0, 1), b2 + hstep, voffB); PG8_STAGE_A(PG8_SA(0, 0), a2, 0, vG);
            PG8_WAIT_V(8); PG8_WAIT_L(0); PG8_BAR; PG8_MMA(1, 0, At, B0); PG8_MMA(1, 1, At, B1); PG8_BAR; PG8_SCHED;
            PG8_LDB(B0, 1, 0); PG8_LDB(B1, 1, 1); PG8_SCHED; PG8_LDA(At, 1, 0); PG8_STAGE_A(PG8_SA(0, 1), a2, 1, vG);
            PG8_WAIT_V(8); PG8_WAIT_L(0); PG8_BAR; PG8_MMA(0, 0, At, B0); PG8_MMA(0, 1, At, B1); PG8_BAR; PG8_SCHED;
            PG8_LDA(At, 1, 1); PG8_STAGE(PG8_SB(1, 0), b3, voffB); PG8_STAGE(PG8_SB(1, 1), b3 + hstep, voffB); PG8_STAGE_A(PG8_SA(1, 0), a3, 0, vG);
            PG8_WAIT_V(8); PG8_WAIT_L(0); PG8_BAR; PG8_MMA(1, 0, At, B0); PG8_MMA(1, 1, At, B1); PG8_BAR; PG8_SCHED;
        }
        if (wr == 0) PG8_BAR;
        if constexpr (PREF) E(acc, cur, wr, wc, fr, fq, (const LAS float*)(g.aux + 2048 + (ui & 1) * 1024)); else E(acc, cur, wr, wc, fr, fq);
        if (!has_next) break;
#pragma unroll
        for (int a = 0; a < 2; ++a)
#pragma unroll
            for (int b = 0; b < 2; ++b)
#pragma unroll
                for (int m = 0; m < 4; ++m)
#pragma unroll
                    for (int n = 0; n < 2; ++n) acc[a][b][m][n] = (f32x4){0.f, 0.f, 0.f, 0.f};
        cur = nxt; cA = nA; cB = nB; ++ui;
        if (wr == 1) PG8_BAR;
    }
    PG8_WAIT_V(0);
    PG8_BAR;
#undef PG8_SA
#undef PG8_SB
#undef PG8_STAGE
#undef PG8_STAGE_A
#undef PG8_LDA
#undef PG8_LDB
#undef PG8_MMA
#undef PG8_LD8
#undef PG8_WAIT_V
#undef PG8_WAIT_L
#undef PG8_BAR
#undef PG8_SCHED
#undef PG8_GATHER
#undef PG8_PREF
#undef PG8_VG_LDS
}
}

struct Frame {
    LAS unsigned char* lds; volatile LAS unsigned* MISC;
    int tid, lane, wave, G, bid;
    float* out; unsigned char* ws;
};
DI const float* inp(const Frame& F, int k) { int z_ = 0; asm volatile("" : "+v"(z_)); volatile LAS unsigned* p = F.MISC + 64 + 2 * k + z_; const unsigned lo = __builtin_amdgcn_readfirstlane(p[0]), hi = __builtin_amdgcn_readfirstlane(p[1]); return (const float*)(const GAS float*)(((unsigned long long)hi << 32) | lo); }
DI unsigned long long lds_u64(volatile LAS unsigned* p0) { int z_ = 0; asm volatile("" : "+v"(z_)); volatile LAS unsigned* p = p0 + z_; const unsigned lo = __builtin_amdgcn_readfirstlane(p[0]), hi = __builtin_amdgcn_readfirstlane(p[1]); return ((unsigned long long)hi << 32) | lo; }
DI Frame refresh(const Frame& F0) { Frame F; F.lds = F0.lds; F.MISC = F0.MISC; F.wave = F0.wave; F.G = gridDim.x; F.bid = blockIdx.x;
    unsigned z_ = 0u; asm volatile("" : "+v"(z_));
    int t = F0.wave * 64 + (int)__builtin_amdgcn_mbcnt_hi(~0u, __builtin_amdgcn_mbcnt_lo(~0u, z_)); asm volatile("" : "+v"(t)); F.tid = t; F.lane = t & 63;
    F.ws = (unsigned char*)(GAS unsigned char*)lds_u64(F0.MISC + 60); F.out = (float*)(GAS float*)lds_u64(F0.MISC + 62); return F; }
#define WSP(T, off) ((T*)(F.ws + (off)))
DI float wave_sum(float v) {
#pragma unroll
    for (int o = 1; o < 64; o <<= 1) v += __shfl_xor(v, o);
    return v;
}
#define LDS_WAIT() asm volatile("s_waitcnt lgkmcnt(0)" ::: "memory")
#define LDS_ADD1(p) ((void)__hip_atomic_fetch_add((LAS int*)(p), 1, __ATOMIC_RELAXED, __HIP_MEMORY_SCOPE_WORKGROUP))

DI void tr_item(const float* W, int K, int N, bf16_t* WT, LAS float* scr, int item, int lane) {
    const int nblk = N >> 6, kb = item / nblk, nb = item - kb * nblk, k0 = kb << 6, n0 = nb << 6;
#pragma unroll 4
    for (int i = 0; i < 16; ++i) { const int kk = 4 * i + (lane >> 4); const f32x4 v = __builtin_nontemporal_load((const f32x4*)(W + (size_t)(k0 + kk) * N + n0 + 4 * (lane & 15)));
        LAS float* d = scr + kk * 65 + 4 * (lane & 15); d[0] = v[0]; d[1] = v[1]; d[2] = v[2]; d[3] = v[3]; }
    LDS_WAIT();
    const int kc = lane & 7;
#pragma unroll
    for (int it = 0; it < 8; ++it) { const int n = 8 * it + (lane >> 3); const LAS float* s = scr + (8 * kc) * 65 + n;
        u32x4 o; o.x = pk2(s[0], s[65]); o.y = pk2(s[2 * 65], s[3 * 65]); o.z = pk2(s[4 * 65], s[5 * 65]); o.w = pk2(s[6 * 65], s[7 * 65]);
        *(u32x4*)(WT + (size_t)(n0 + n) * K + k0 + 8 * kc) = o; }
    LDS_WAIT();
}
DI void tr_item8(const float* W, int K, int N, unsigned char* WT, float sc, LAS float* scr, int item, int lane) {
    const int nblk = N >> 6, kb = item / nblk, nb = item - kb * nblk, k0 = kb << 6, n0 = nb << 6;
#pragma unroll 4
    for (int i = 0; i < 16; ++i) { const int kk = 4 * i + (lane >> 4); const f32x4 v = __builtin_nontemporal_load((const f32x4*)(W + (size_t)(k0 + kk) * N + n0 + 4 * (lane & 15)));
        LAS float* d = scr + kk * 65 + 4 * (lane & 15); d[0] = v[0]; d[1] = v[1]; d[2] = v[2]; d[3] = v[3]; }
    LDS_WAIT();
    const int kc = lane & 7;
#pragma unroll
    for (int it = 0; it < 8; ++it) { const int n = 8 * it + (lane >> 3); const LAS float* s = scr + (8 * kc) * 65 + n;
        u32x2 o; o.x = pk4f8(s[0] * sc, s[65] * sc, s[2 * 65] * sc, s[3 * 65] * sc); o.y = pk4f8(s[4 * 65] * sc, s[5 * 65] * sc, s[6 * 65] * sc, s[7 * 65] * sc);
        *(u32x2*)(WT + (size_t)(n0 + n) * K + k0 + 8 * kc) = o; }
    LDS_WAIT();
}
DI void tr_item8g(const float* W, int K, int ldw, int NC, unsigned char* WT, float sc, LAS float* scr, int item, int lane) {
    const int nblk = NC >> 6, kb = item / nblk, nb = item - kb * nblk, k0 = kb << 6, n0 = nb << 6;
#pragma unroll 4
    for (int i = 0; i < 16; ++i) { const int kk = 4 * i + (lane >> 4); const f32x4 v = __builtin_nontemporal_load((const f32x4*)(W + (size_t)(k0 + kk) * ldw + n0 + 4 * (lane & 15)));
        LAS float* d = scr + kk * 65 + 4 * (lane & 15); d[0] = v[0]; d[1] = v[1]; d[2] = v[2]; d[3] = v[3]; }
    LDS_WAIT();
    const int kc = lane & 7;
#pragma unroll
    for (int it = 0; it < 8; ++it) { const int n = 8 * it + (lane >> 3); const LAS float* s = scr + (8 * kc) * 65 + n;
        u32x2 o; o.x = pk4f8(s[0] * sc, s[65] * sc, s[2 * 65] * sc, s[3 * 65] * sc); o.y = pk4f8(s[4 * 65] * sc, s[5 * 65] * sc, s[6 * 65] * sc, s[7 * 65] * sc);
        *(u32x2*)(WT + (size_t)(n0 + n) * K + k0 + 8 * kc) = o; }
    LDS_WAIT();
}
DI void ln_rowv(f32x4 (&v)[4], const float* g, const float* b, int lane) {
    float s = 0.f;
#pragma unroll
    for (int j = 0; j < 4; ++j) s += (v[j][0] + v[j][1]) + (v[j][2] + v[j][3]);
    const float mean = wave_sum(s) * (1.f / DM); float s2 = 0.f;
#pragma unroll
    for (int j = 0; j < 4; ++j) { v[j] = v[j] - mean; s2 += (v[j][0] * v[j][0] + v[j][1] * v[j][1]) + (v[j][2] * v[j][2] + v[j][3] * v[j][3]); }
    const float rstd = 1.f / sqrtf(wave_sum(s2) * (1.f / DM) + LN_EPS);
#pragma unroll
    for (int j = 0; j < 4; ++j) { const f32x4 gg = *(const f32x4*)(g + 4 * lane + 256 * j), bb = *(const f32x4*)(b + 4 * lane + 256 * j); v[j] = v[j] * rstd * gg + bb; }
}
DI void store_row_f32(float* row, const f32x4 (&v)[4], int lane) {
#pragma unroll
    for (int j = 0; j < 4; ++j) *(f32x4*)(row + 4 * lane + 256 * j) = v[j];
}
DI void store_row_f8(unsigned char* row, const f32x4 (&v)[4], int lane, float sc) {
#pragma unroll
    for (int j = 0; j < 4; ++j) *(unsigned*)(row + 4 * lane + 256 * j) = pk4f8(v[j][0] * sc, v[j][1] * sc, v[j][2] * sc, v[j][3] * sc);
}
DI void store_row_bf16(bf16_t* row, const f32x4 (&v)[4], int lane) {
#pragma unroll
    for (int j = 0; j < 4; ++j) { u32x2 w; w.x = pk2(v[j][0], v[j][1]); w.y = pk2(v[j][2], v[j][3]); *(u32x2*)(row + 4 * lane + 256 * j) = w; }
}

DI void phase_proA(const Frame& F_) {
    const Frame F = refresh(F_);
    const int gw = F.bid * 8 + F.wave, NGW = F.G * 8;
    if (EN(16)) {
        LAS float* scr = (LAS float*)(F.lds + F.wave * 16640);
        constexpr int I_WIN = 4 * 16 * 92, I_WKV = 4 * 16 * 16, I_BR = 4 * 8 * 16, I_WOUT = 4 * 16 * 16, I_W1 = 128 * 16 * 32, I_W2 = 128 * 16 * 16;
        constexpr int I_WG = 4 * 16 * 48; constexpr int NIT = I_WIN + I_WKV + 3 * I_BR + I_WOUT + I_W1 + I_W2 + I_WG;
        for (int it = gw; it < NIT; it += NGW) {
            int r = it;
#ifdef TR_LIM
            if (r >= TR_LIM) break;
#endif
            if (r < I_W1) { const int mat = r >> 9, i = r & 511; tr_item8(inp(F, 25) + (size_t)mat * 1024 * 2048, 1024, 2048, WSP(unsigned char, WS_W1) + (size_t)mat * 2048 * 1024, 64.0f, scr, i, F.lane); continue; } r -= I_W1;
            if (r < I_W2) { const int mat = r >> 8, i = r & 255; tr_item8(inp(F, 27) + (size_t)mat * 1024 * 1024, 1024, 1024, WSP(unsigned char, WS_W2) + (size_t)mat * 1024 * 1024, 128.0f, scr, i, F.lane); continue; } r -= I_W2;
            if (r < I_WIN) { const int mat = r / 1472, i = r % 1472; tr_item(inp(F, 4) + (size_t)mat * 1024 * INC, 1024, INC, WSP(bf16_t, WS_WIN) + (size_t)mat * INC * 1024, scr, i, F.lane); continue; } r -= I_WIN;
            if (r < I_WKV) { const int mat = r >> 8, i = r & 255; tr_item(inp(F, 16) + (size_t)mat * 1024 * 1024, 1024, 1024, WSP(bf16_t, WS_WKV) + (size_t)mat * 1024 * 1024, scr, i, F.lane); continue; } r -= I_WKV;
            if (r < I_BR) { const int mat = r >> 7, i = r & 127; tr_item(inp(F, 17) + (size_t)mat * 512 * 1024, 512, 1024, WSP(bf16_t, WS_WBR) + ((size_t)0 * 4 + mat) * 1024 * 512, scr, i, F.lane); continue; } r -= I_BR;
            if (r < I_BR) { const int mat = r >> 7, i = r & 127; tr_item(inp(F, 18) + (size_t)mat * 512 * 1024, 512, 1024, WSP(bf16_t, WS_WBR) + ((size_t)1 * 4 + mat) * 1024 * 512, scr, i, F.lane); continue; } r -= I_BR;
            if (r < I_BR) { const int mat = r >> 7, i = r & 127; tr_item(inp(F, 19) + (size_t)mat * 512 * 1024, 512, 1024, WSP(bf16_t, WS_WBR) + ((size_t)2 * 4 + mat) * 1024 * 512, scr, i, F.lane); continue; } r -= I_BR;
            if (r < I_WOUT) { const int mat = r >> 8, i = r & 255; tr_item(inp(F, 20) + (size_t)mat * 1024 * 1024, 1024, 1024, WSP(bf16_t, WS_WOUT) + (size_t)mat * 1024 * 1024, scr, i, F.lane); continue; } r -= I_WOUT;
            { const int mat = r / 768, i = r % 768; tr_item8g(inp(F, 4) + (size_t)mat * 1024 * INC + 2816, 1024, INC, 3072, WSP(unsigned char, WS_WG8) + (size_t)mat * 3072 * 1024, 64.0f, scr, i, F.lane); }
        }
    }
    if (EN(17)) for (int m = gw; m < NTOK; m += NGW) {
        f32x4 v[4];
#pragma unroll
        for (int j = 0; j < 4; ++j) v[j] = *(const f32x4*)(inp(F, 0) + (size_t)m * DM + 4 * F.lane + 256 * j);
        ln_rowv(v, inp(F, 2), inp(F, 3), F.lane);
        store_row_bf16(WSP(bf16_t, WS_XB) + (size_t)m * DM, v, F.lane); store_row_f8(WSP(unsigned char, WS_X8) + (size_t)m * DM, v, F.lane, 16.0f);
    }
    for (int m = gw; m < 512; m += NGW) {
        f32x4 v[4];
#pragma unroll
        for (int j = 0; j < 4; ++j) v[j] = *(const f32x4*)(inp(F, 1) + (size_t)m * DM + 4 * F.lane + 256 * j);
        store_row_bf16(WSP(bf16_t, WS_MEMB) + (size_t)m * DM, v, F.lane);
    }
    { const int gt = F.bid * 512 + F.tid, NT = F.G * 512;
      for (int i = gt; i < 4 * 32 * 1024; i += NT) { const int l = i >> 15, e = (i >> 10) & 31, k = i & 1023; const float w = inp(F, 23)[((size_t)l * 1024 + k) * 32 + e];
          const unsigned hi = pk2(w, 0.f) & 0xffffu; const unsigned lo = pk2(w - bflo(hi), 0.f) & 0xffffu; bf16_t* d = WSP(bf16_t, WS_RW) + (size_t)l * 2 * 32 * 1024 + (size_t)e * 1024 + k; d[0] = (bf16_t)hi; d[32 * 1024] = (bf16_t)lo; }
      for (int i = gt; i < PMAX; i += NT) WSP(int, WS_ROUTE + RT_IOTA)[i] = i;
      { const float inv[8] = {1.0f, 1.939227432e-01f, 3.760603070e-02f, 7.292664610e-03f, 1.414213562e-03f, 2.742481884e-04f, 5.318295734e-05f, 1.031338525e-05f};
        for (int i = gt; i < SEQ; i += NT) {
#pragma unroll
            for (int j = 0; j < 8; ++j) { const double rev = (double)((float)i * inv[j]) * 0.15915494309189535; const float fr2 = (float)(2.0 * (rev - floor(rev))); float sn, cs; sincospif(fr2, &sn, &cs);
                WSP(f32x2, WS_ROPE)[i * 8 + j] = (f32x2){cs, sn}; } } }
      for (int i = gt; i < 4 * 2048 * 64; i += NT) { const int l = i >> 17, n = (i >> 6) & 2047, k = i & 63; const float w = inp(F, 12)[((size_t)l * 64 + k) * 2048 + n];
          const unsigned hi = pk2(w, 0.f) & 0xffffu; const unsigned lo = pk2(w - bflo(hi), 0.f) & 0xffffu; bf16_t* d = WSP(bf16_t, WS_FW) + ((size_t)l * 2048 + n) * 256;
          d[k] = (bf16_t)hi; d[64 + k] = (bf16_t)hi; d[128 + k] = (bf16_t)lo; d[192 + k] = 0; }
    }
    __syncthreads();
    if (EN(18)) {
        LAS float* zs = (LAS float*)F.lds;
        LAS float* ha = zs + 64 * 33;
        LAS float* hb = ha + 64 * 65;
        for (int u = F.bid; u < 4 * 256; u += F.G) {
            const int l = u >> 8, t0 = (u & 255) * 64;
            for (int idx = F.tid; idx < 64 * 33; idx += 512) { const int tt = idx / 33, f = idx - tt * 33, t = t0 + tt; float val;
                if (f == 0) val = (float)t * (1.0f / (float)(SEQ - 1));
                else { const int bi = (f - 1) & 15; const double band = 1e-4 + (double)bi * ((15.0 - 1e-4) / 15.0); const double rev = band * (double)t * (1.0 / (double)SEQ); const float fr2 = (float)(2.0 * (rev - floor(rev)));
                    float s, c; sincospif(fr2, &s, &c); val = (f <= 16) ? c : -s; }
                zs[idx] = val; }
            __syncthreads();
            const int tt = F.tid >> 3, j0 = (F.tid & 7) * 8;
            const float* f1w = inp(F, 8) + (size_t)l * 33 * 64; const float* f1b = inp(F, 9) + l * 64; const float* frq = inp(F, 13) + l * 64;
            { float a[8];
#pragma unroll
              for (int j = 0; j < 8; ++j) a[j] = f1b[j0 + j];
              for (int f = 0; f < 33; ++f) { const float z = zs[tt * 33 + f];
#pragma unroll
                  for (int j = 0; j < 8; ++j) a[j] += z * f1w[f * 64 + j0 + j]; }
#pragma unroll
              for (int j = 0; j < 8; ++j) ha[tt * 65 + j0 + j] = __sinf(frq[j0 + j] * a[j]); }
            __syncthreads();
#pragma unroll 1
            for (int i = 0; i < 2; ++i) {
                const float* f2w = inp(F, 10) + ((size_t)l * 2 + i) * 64 * 64; const float* f2b = inp(F, 11) + (l * 2 + i) * 64;
                LAS float* src = i ? hb : ha; LAS float* dst = i ? ha : hb;
                float a[8];
#pragma unroll
                for (int j = 0; j < 8; ++j) a[j] = f2b[j0 + j];
                for (int f = 0; f < 64; ++f) { const float z = src[tt * 65 + f];
#pragma unroll
                    for (int j = 0; j < 8; ++j) a[j] += z * f2w[f * 64 + j0 + j]; }
#pragma unroll
                for (int j = 0; j < 8; ++j) dst[tt * 65 + j0 + j] = __sinf(frq[j0 + j] * a[j]);
                __syncthreads();
            }
            { bf16_t* d = WSP(bf16_t, WS_FH) + ((size_t)l * SEQ + t0 + tt) * 256;
#pragma unroll
              for (int j = 0; j < 8; ++j) { const float h = ha[tt * 65 + j0 + j]; const unsigned hi = pk2(h, 0.f) & 0xffffu; const unsigned lo = pk2(h - bflo(hi), 0.f) & 0xffffu;
                  d[j0 + j] = (bf16_t)hi; d[64 + j0 + j] = (bf16_t)lo; d[128 + j0 + j] = (bf16_t)hi; d[192 + j0 + j] = 0; } }
            __syncthreads();
        }
    }
}

DI constexpr int br5(int x) { return ((x & 1) << 4) | ((x & 2) << 2) | (x & 4) | ((x & 8) >> 2) | ((x & 16) >> 4); }
DI float c32(int k) { switch (k & 15) { case 0: return 1.f; case 1: return 0.980785280f; case 2: return 0.923879533f; case 3: return 0.831469612f; case 4: return 0.707106781f; case 5: return 0.555570233f; case 6: return 0.382683432f; case 7: return 0.195090322f;
    case 8: return 0.f; case 9: return -0.195090322f; case 10: return -0.382683432f; case 11: return -0.555570233f; case 12: return -0.707106781f; case 13: return -0.831469612f; case 14: return -0.923879533f; default: return -0.980785280f; } }
DI float s32(int k) { switch (k & 15) { case 0: return 0.f; case 1: return 0.195090322f; case 2: return 0.382683432f; case 3: return 0.555570233f; case 4: return 0.707106781f; case 5: return 0.831469612f; case 6: return 0.923879533f; case 7: return 0.980785280f;
    case 8: return 1.f; case 9: return 0.980785280f; case 10: return 0.923879533f; case 11: return 0.831469612f; case 12: return 0.707106781f; case 13: return 0.555570233f; case 14: return 0.382683432f; default: return 0.195090322f; } }
DI float c64(int k) { return (k & 1) ? ((k < 16) ? ((k == 1) ? 0.995184727f : (k == 3) ? 0.956940336f : (k == 5) ? 0.881921264f : (k == 7) ? 0.773010453f : (k == 9) ? 0.634393284f : (k == 11) ? 0.471396737f : (k == 13) ? 0.290284677f : 0.098017140f)
                                                 : ((k == 17) ? -0.098017140f : (k == 19) ? -0.290284677f : (k == 21) ? -0.471396737f : (k == 23) ? -0.634393284f : (k == 25) ? -0.773010453f : (k == 27) ? -0.881921264f : (k == 29) ? -0.956940336f : -0.995184727f))
                               : ((k < 16) ? c32(k >> 1) : c32(k >> 1)); }
DI float s64(int k) { return (k & 1) ? ((k < 16) ? ((k == 1) ? 0.098017140f : (k == 3) ? 0.290284677f : (k == 5) ? 0.471396737f : (k == 7) ? 0.634393284f : (k == 9) ? 0.773010453f : (k == 11) ? 0.881921264f : (k == 13) ? 0.956940336f : 0.995184727f)
                                                 : ((k == 17) ? 0.995184727f : (k == 19) ? 0.956940336f : (k == 21) ? 0.881921264f : (k == 23) ? 0.773010453f : (k == 25) ? 0.634393284f : (k == 27) ? 0.471396737f : (k == 29) ? 0.290284677f : 0.098017140f))
                               : s32(k >> 1); }
template <int N, int SPAN> DI void dif_stage(float (&re)[N], float (&im)[N]) {
#pragma unroll
    for (int i = 0; i < N; ++i) {
        if ((i & SPAN) == 0) {
            const int j = i + SPAN, tw = (i & (SPAN - 1)) * (N / (2 * SPAN)) * (32 / N);
            const float ar = re[i], ai = im[i], br_ = re[j], bi = im[j];
            re[i] = ar + br_; im[i] = ai + bi;
            const float dr = ar - br_, di = ai - bi;
            if (tw == 0) { re[j] = dr; im[j] = di; }
            else if (tw == 8) { re[j] = di; im[j] = -dr; }
            else { const float c = c32(tw), s = s32(tw); re[j] = dr * c + di * s; im[j] = di * c - dr * s; }
        }
    }
    if constexpr (SPAN > 1) dif_stage<N, SPAN / 2>(re, im);
}
template <int N> DI void dif(float (&re)[N], float (&im)[N]) { dif_stage<N, N / 2>(re, im); }
template <int N, int SPAN> DI void dit_stage(float (&re)[N], float (&im)[N]) {
#pragma unroll
    for (int i = 0; i < N; ++i) {
        if ((i & SPAN) == 0) {
            const int j = i + SPAN, tw = (i & (SPAN - 1)) * (N / (2 * SPAN)) * (32 / N);
            const float br_ = re[j], bi = im[j]; float tr, ti;
            if (tw == 0) { tr = br_; ti = bi; }
            else if (tw == 8) { tr = bi; ti = -br_; }
            else { const float c = c32(tw), s = s32(tw); tr = br_ * c + bi * s; ti = bi * c - br_ * s; }
            const float ar = re[i], ai = im[i];
            re[j] = ar - tr; im[j] = ai - ti; re[i] = ar + tr; im[i] = ai + ti;
        }
    }
    if constexpr (SPAN * 2 < N) dit_stage<N, SPAN * 2>(re, im);
}
template <int N> DI void dit(float (&re)[N], float (&im)[N]) { dit_stage<N, 1>(re, im); }
DI void tw_powers(float w1r, float w1i, float (&wr)[32], float (&wi)[32]) {
    wr[0] = 1.f; wi[0] = 0.f; wr[1] = w1r; wi[1] = w1i;
#pragma unroll
    for (int k = 2; k < 32; ++k) {
        if ((k & 1) == 0) { const float a = wr[k >> 1], b = wi[k >> 1]; wr[k] = a * a - b * b; wi[k] = 2.f * a * b; }
        else { const float a = wr[k - 1], b = wi[k - 1]; wr[k] = a * w1r - b * w1i; wi[k] = a * w1i + b * w1r; }
    }
}
#define OPQ(x) asm volatile("" : "+v"(x))
constexpr int FB = 528;
#define TW_STEP(wr, wi, w1r, w1i) do { const float t_ = wr * w1r - wi * w1i; wi = wr * w1i + wi * w1r; wr = t_; } while (0)
DI void fft_fwd(float (&zr)[32], float (&zi)[32], LAS f32x2* lds, int tid_) {
    dif<32>(zr, zi);
    int tid = tid_; OPQ(tid);
    { float s1, c1; s1 = __builtin_amdgcn_sinf(0.5f * ((float)tid * (1.0f / 8192.0f))); c1 = __builtin_amdgcn_cosf(0.5f * ((float)tid * (1.0f / 8192.0f))); const float w1r = c1, w1i = -s1; float wr = 1.f, wi = 0.f;
#pragma unroll
      for (int k = 0; k < 32; ++k) { const float a = zr[br5(k)], b = zi[br5(k)]; lds[k * FB + tid] = (f32x2){a * wr - b * wi, a * wi + b * wr}; TW_STEP(wr, wi, w1r, w1i); if ((k & 3) == 3) __builtin_amdgcn_sched_barrier(0); } }
    __syncthreads();
    tid = tid_; OPQ(tid);
    const int blk = tid >> 4, n2 = tid & 15;
#pragma unroll
    for (int j = 0; j < 32; ++j) { const f32x2 v = lds[blk * FB + 16 * j + n2]; zr[j] = v.x; zi[j] = v.y; }
    __syncthreads();
    dif<32>(zr, zi);
    { float s1, c1; s1 = __builtin_amdgcn_sinf(0.5f * ((float)n2 * (1.0f / 256.0f))); c1 = __builtin_amdgcn_cosf(0.5f * ((float)n2 * (1.0f / 256.0f))); const float w1r = c1, w1i = -s1; float wr = 1.f, wi = 0.f;
#pragma unroll
      for (int k = 0; k < 32; ++k) { const float a = zr[br5(k)], b = zi[br5(k)]; lds[blk * FB + n2 * 33 + k] = (f32x2){a * wr - b * wi, a * wi + b * wr}; TW_STEP(wr, wi, w1r, w1i); if ((k & 3) == 3) __builtin_amdgcn_sched_barrier(0); } }
    __syncthreads();
#pragma unroll
    for (int r = 0; r < 2; ++r) { float cr[16], ci[16];
#pragma unroll
        for (int n = 0; n < 16; ++n) { const f32x2 v = lds[blk * FB + n * 33 + n2 + 16 * r]; cr[n] = v.x; ci[n] = v.y; }
        dif<16>(cr, ci);
#pragma unroll
        for (int q = 0; q < 16; ++q) { zr[r * 16 + q] = cr[q]; zi[r * 16 + q] = ci[q]; } }
    __syncthreads();
}
DI void fft_inv(float (&zr)[32], float (&zi)[32], LAS f32x2* lds, int tid_) {
    int tid = tid_; OPQ(tid);
    const int blk = tid >> 4, n2 = tid & 15;
#pragma unroll
    for (int r = 0; r < 2; ++r) { float cr[16], ci[16];
#pragma unroll
        for (int q = 0; q < 16; ++q) { cr[q] = zr[r * 16 + q]; ci[q] = -zi[r * 16 + q]; }
        dit<16>(cr, ci);
#pragma unroll
        for (int n = 0; n < 16; ++n) lds[blk * FB + n * 33 + n2 + 16 * r] = (f32x2){cr[n], ci[n]}; }
    __syncthreads();
    { float wr[32], wi[32]; float s1, c1; s1 = __builtin_amdgcn_sinf(0.5f * ((float)n2 * (1.0f / 256.0f))); c1 = __builtin_amdgcn_cosf(0.5f * ((float)n2 * (1.0f / 256.0f))); tw_powers(c1, -s1, wr, wi);
#pragma unroll
      for (int k = 0; k < 32; ++k) { const f32x2 v = lds[blk * FB + n2 * 33 + k]; zr[k] = v.x * wr[k] - v.y * wi[k]; zi[k] = v.x * wi[k] + v.y * wr[k]; } }
    __syncthreads();
    dif<32>(zr, zi);
#pragma unroll
    for (int j = 0; j < 32; ++j) lds[blk * FB + 16 * j + n2] = (f32x2){zr[br5(j)], zi[br5(j)]};
    __syncthreads();
    { int tid2 = tid_; OPQ(tid2); float wr[32], wi[32]; float s1, c1; s1 = __builtin_amdgcn_sinf(0.5f * ((float)tid2 * (1.0f / 8192.0f))); c1 = __builtin_amdgcn_cosf(0.5f * ((float)tid2 * (1.0f / 8192.0f))); tw_powers(c1, -s1, wr, wi);
#pragma unroll
      for (int k = 0; k < 32; ++k) { const f32x2 v = lds[k * FB + tid2]; zr[k] = v.x * wr[k] - v.y * wi[k]; zi[k] = v.x * wi[k] + v.y * wr[k]; } }
    __syncthreads();
    dif<32>(zr, zi);
    float tr[32], ti[32];
#pragma unroll
    for (int j = 0; j < 32; ++j) { tr[j] = zr[br5(j)] * (1.0f / (float)SEQ); ti[j] = -zi[br5(j)] * (1.0f / (float)SEQ); }
#pragma unroll
    for (int j = 0; j < 32; ++j) { zr[j] = tr[j]; zi[j] = ti[j]; }
}
DI void hyena_unit(const Frame& F_, int l, int c) {
    const Frame F = refresh(F_);
    LAS f32x2* lds = (LAS f32x2*)F.lds; const int tid0 = F.tid; constexpr int L = SEQ;
#define TWIST(j, wr, wi) const float wr = twr_ * c64(j) + twi_ * s64(j), wi = twi_ * c64(j) - twr_ * s64(j)
    bf16_t* y2 = WSP(bf16_t, WS_Y2) + (size_t)c * NTOK;
    unsigned* SP = WSP(unsigned, WS_FFTS) + (size_t)F.bid * 131072; unsigned* ZS = SP + 65536; unsigned* YE = SP + 81920; unsigned* GX = SP + 98304;
    { const bf16_t* ZT = WSP(bf16_t, WS_ZT); const float* cw = inp(F, 6) + (size_t)l * 3 * 1536; const float* cb = inp(F, 7) + l * 1536;
#pragma unroll 1
      for (int part = 0; part < 3; ++part) { const int ch = part * 512 + c; const bf16_t* z0 = ZT + (size_t)ch * NTOK; const float w0 = cw[ch], w1 = cw[1536 + ch], w2 = cw[3072 + ch], bb = cb[ch];
          unsigned* dst = part == 0 ? ZS : GX + (size_t)(part - 1) * 16384;
#pragma unroll 4
          for (int ck = tid0; ck < 2048; ck += 512) { const unsigned t0 = 8u * (unsigned)ck;
              float za[10], zb[10];
              { const u32x4 v = *(const u32x4*)(z0 + t0), w = *(const u32x4*)(z0 + L + t0);
#pragma unroll
                for (int q = 0; q < 4; ++q) { za[1 + 2 * q] = bflo(v[q]); za[2 + 2 * q] = bfhi(v[q]); zb[1 + 2 * q] = bflo(w[q]); zb[2 + 2 * q] = bfhi(w[q]); } }
              const unsigned tm = (t0 > 0u) ? t0 - 1u : 0u, tp = (t0 + 8u < (unsigned)L) ? t0 + 8u : t0;
              za[0] = bflo((unsigned)z0[tm]); zb[0] = bflo((unsigned)z0[L + tm]); za[9] = bflo((unsigned)z0[tp]); zb[9] = bflo((unsigned)z0[L + tp]);
              if (t0 == 0u) { za[0] = 0.f; zb[0] = 0.f; } if (t0 + 8u == (unsigned)L) { za[9] = 0.f; zb[9] = 0.f; }
              u32x4 o0, o1;
#pragma unroll
              for (int q = 0; q < 8; ++q) { const unsigned w = pkh(w0 * za[q] + w1 * za[q + 1] + w2 * za[q + 2] + bb, w0 * zb[q] + w1 * zb[q + 1] + w2 * zb[q + 2] + bb); if (q < 4) o0[q] = w; else o1[q - 4] = w; }
              *(u32x4*)(dst + t0) = o0; *(u32x4*)(dst + t0 + 4) = o1; } } }
    float twr, twi; { float s, cc; s = __builtin_amdgcn_sinf(0.5f * ((float)tid0 * (1.0f / 16384.0f))); cc = __builtin_amdgcn_cosf(0.5f * ((float)tid0 * (1.0f / 16384.0f))); twr = cc; twi = -s; }
#define TWIST_NEXT(wr, wi) do { const float t_ = wr * 0.995184727f + wi * 0.098017140f; wi = wi * 0.995184727f - wr * 0.098017140f; wr = t_; } while (0)
    { const _Float16* hf0 = WSP(_Float16, WS_HF) + ((size_t)l * 2048 + c) * L;
      const float skip0 = inp(F, 14)[(l * 2 + 0) * 512 + c], skip1 = inp(F, 14)[(l * 2 + 1) * 512 + c];
      const float dl = (3.070113457325394f + (float)c * ((15.350567286626971f - 3.070113457325394f) / 511.0f)) * (1.4426950408889634f / (float)(SEQ - 1));
#pragma unroll 1
      for (int par = 0; par < 2; ++par) {
        float ar[32], ai[32];
        { unsigned tid = tid0; OPQ(tid); float twr_ = twr, twi_ = twi; OPQ(twr_); OPQ(twi_);
#pragma unroll
          for (int j = 0; j < 32; ++j) { const unsigned m = 512u * j + tid; const unsigned mb = (m > 0u) ? (unsigned)L - m : 1u;
              const float wf = __builtin_amdgcn_exp2f(-(float)m * dl - 8.0f), wb = (m > 0u) ? __builtin_amdgcn_exp2f(-(float)mb * dl - 8.0f) : 0.f;
              float f0 = (float)hf0[m] * wf, f1 = (float)hf0[(size_t)1024 * L + m] * wf; const float b0 = (float)hf0[(size_t)512 * L + mb] * wb, b1 = (float)hf0[(size_t)1536 * L + mb] * wb;
              if (j == 0) { f0 += (tid == 0u) ? skip0 : 0.f; f1 += (tid == 0u) ? skip1 : 0.f; }
              if (par == 0) { ar[j] = f0 + b0; ai[j] = f1 + b1; }
              else { const float d0 = f0 - b0, d1 = f1 - b1; ar[j] = d0 * twr_ - d1 * twi_; ai[j] = d0 * twi_ + d1 * twr_; TWIST_NEXT(twr_, twi_); }
              if ((j & 3) == 3) __builtin_amdgcn_sched_barrier(0); } }
        fft_fwd(ar, ai, lds, tid0);
        { unsigned tid = tid0; OPQ(tid);
#pragma unroll
          for (int i = 0; i < 32; ++i) lds[i * 512u + tid] = (f32x2){ar[i], ai[i]};
          __syncthreads();
          unsigned* S0 = SP + (size_t)par * 16384; unsigned* S1 = SP + 32768 + (size_t)par * 16384;
#pragma unroll
          for (int i = 0; i < 32; ++i) {
              unsigned pidx;
              if (par == 1) pidx = (unsigned)(31 - i) * 512u + (511u - tid);
              else if (tid >= 16u) pidx = (unsigned)(31 - i) * 512u + ((32u - (tid >> 4)) * 16u + 15u - (tid & 15u));
              else { const unsigned k1p = (tid & 15u) + 16u * (unsigned)(i >> 4); const unsigned qq = (unsigned)(i & 15);
                     if (k1p != 0u) { const unsigned nk = 32u - k1p; pidx = ((nk >> 4) * 16u + 15u - qq) * 512u + (nk & 15u); }
                     else { const unsigned k2 = ((qq & 1u) << 3) | ((qq & 2u) << 1) | ((qq & 4u) >> 1) | ((qq & 8u) >> 3); const unsigned nk2 = (16u - k2) & 15u;
                            const unsigned nq = ((nk2 & 1u) << 3) | ((nk2 & 2u) << 1) | ((nk2 & 4u) >> 1) | ((nk2 & 8u) >> 3); pidx = nq * 512u; } }
              const f32x2 p = lds[pidx];
              const float sr = 0.5f * (ar[i] + p.x), si = 0.5f * (ai[i] - p.y), dr = 0.5f * (ar[i] - p.x), di = 0.5f * (ai[i] + p.y);
              S0[i * 512u + tid] = pkh(sr, si); S1[i * 512u + tid] = pkh(di, -dr); }
          __syncthreads(); }
      } }
#pragma unroll 1
    for (int o = 0; o < 2; ++o) {
        const unsigned* gx = GX + (size_t)o * 16384;
        float ar[32], ai[32];
        const unsigned* SPE = SP + (size_t)o * 32768; const unsigned* SPO = SPE + 16384;
        { unsigned tid = tid0; OPQ(tid);
#pragma unroll
          for (int j = 0; j < 32; ++j) { const f32x2 v = unh(ZS[j * 512u + tid]); ar[j] = v.x; ai[j] = v.y; } }
        fft_fwd(ar, ai, lds, tid0);
        { unsigned tid = tid0; OPQ(tid);
#pragma unroll
          for (int i = 0; i < 32; ++i) { const f32x2 k = unh(SPE[i * 512u + tid]); const float a = ar[i], b = ai[i]; ar[i] = a * k.x - b * k.y; ai[i] = a * k.y + b * k.x; } }
        fft_inv(ar, ai, lds, tid0);
        { unsigned tid = tid0; OPQ(tid);
#pragma unroll
          for (int j = 0; j < 32; ++j) YE[j * 512u + tid] = pkh(ar[j], ai[j]); }
        { unsigned tid = tid0; OPQ(tid); float twr_ = twr, twi_ = twi; OPQ(twr_); OPQ(twi_);
#pragma unroll
          for (int j = 0; j < 32; ++j) { const f32x2 v = unh(ZS[j * 512u + tid]); ar[j] = v.x; ai[j] = v.y; }
#pragma unroll
          for (int j = 0; j < 32; ++j) { TWIST(j, wr, wi); const float a = ar[j], b = ai[j]; ar[j] = a * wr - b * wi; ai[j] = a * wi + b * wr; } }
        fft_fwd(ar, ai, lds, tid0);
        { unsigned tid = tid0; OPQ(tid);
#pragma unroll
          for (int i = 0; i < 32; ++i) { const f32x2 k = unh(SPO[i * 512u + tid]); const float a = ar[i], b = ai[i]; ar[i] = a * k.x - b * k.y; ai[i] = a * k.y + b * k.x; } }
        fft_inv(ar, ai, lds, tid0);
        { unsigned tid = tid0; OPQ(tid); float twr_ = twr, twi_ = twi; OPQ(twr_); OPQ(twi_);
#pragma unroll
          for (int j = 0; j < 32; ++j) { const unsigned n = 512u * j + tid;
            TWIST(j, wr, wi);
            const float yor = ar[j] * wr + ai[j] * wi, yoi = ai[j] * wr - ar[j] * wi;
            const f32x2 ye = unh(YE[j * 512u + tid]);
            const f32x2 gg = unh(gx[j * 512u + tid]);
            const float o0 = gg.x * 0.5f * (ye.x + yor), o1 = gg.y * 0.5f * (ye.y + yoi);
            if (o == 0) ZS[j * 512u + tid] = pkh(o0, o1); else { y2[n] = (bf16_t)(pk2(o0, 0.f) & 0xffffu); y2[(unsigned)L + n] = (bf16_t)(pk2(o1, 0.f) & 0xffffu); }
            if ((j & 3) == 3) __builtin_amdgcn_sched_barrier(0); } }
        __syncthreads();
    }
#undef TWIST
}

DI int crow(int reg, int h) { return (reg & 3) + 8 * (reg >> 2) + 4 * h; }
template <int NKT, int NST, int NDT, bool SWA>
DI void attn_sub(const LAS unsigned char* Ks, int kstride, const LAS unsigned char* Vt, int vstride, int key0,
                 const bf16_t* qptr, bf16_t* optr, float scale, float sink, int kpos0, int lane, const f32x4* rt = nullptr) {
    const int r = lane & 31, h = lane >> 5;
    int rq = r; OPQ(rq);
    bf16x8 q[NST];
#pragma unroll
    for (int s = 0; s < NST; ++s) q[s] = *(const bf16x8*)(qptr + 16 * s + 8 * h);
    if (SWA) {
        u32x4 mine = __builtin_bit_cast(u32x4, q[0]), oth, res;
#pragma unroll
        for (int j = 0; j < 4; ++j) oth[j] = (unsigned)__shfl_xor((int)mine[j], 32);
#pragma unroll
        for (int j = 0; j < 4; ++j) { const f32x4 cs = rt[j]; const float m0 = bflo(mine[j]), m1 = bfhi(mine[j]), o0 = bflo(oth[j]), o1 = bfhi(oth[j]);
            res[j] = h ? pk2(m0 * cs[0] + o0 * cs[1], m1 * cs[2] + o1 * cs[3]) : pk2(m0 * cs[0] - o0 * cs[1], m1 * cs[2] - o1 * cs[3]); }
        q[0] = __builtin_bit_cast(bf16x8, res);
    }
    f32x16 O[NDT];
#pragma unroll
    for (int dt = 0; dt < NDT; ++dt)
#pragma unroll
        for (int x = 0; x < 16; ++x) O[dt][x] = 0.f;
    const float sink2 = sink * 1.4426950408889634f;
    float m = SWA ? sink2 : -3.0e38f, lsum = 0.f;
#pragma unroll
    for (int i = 0; i < NKT; ++i) {
        f32x16 a16;
#pragma unroll
        for (int x = 0; x < 16; ++x) a16[x] = 0.f;
#pragma unroll
        for (int s = 0; s < NST; ++s) { const bf16x8 a = *(const LAS bf16x8*)(Ks + (key0 + 32 * i + r) * kstride + (16 * s + 8 * h) * 2); a16 = __builtin_amdgcn_mfma_f32_32x32x16_bf16(a, q[s], a16, 0, 0, 0); }
        float tmax = -3.0e38f;
#pragma unroll
        for (int x = 0; x < 16; ++x) { float v = a16[x] * (scale * 1.4426950408889634f);
            if (SWA) { const int kk = 32 * i + crow(x, h); const int d = kk - 128 - rq; bool valid = (unsigned)(kpos0 + kk) < (unsigned)SEQ;
                if (i == 0) valid = valid && (d >= -128); if (i == NKT - 1) valid = valid && (d <= 128); v = valid ? v : -1e30f; }
            a16[x] = v; tmax = fmaxf(tmax, v); }
        tmax = fmaxf(tmax, __shfl_xor(tmax, 32));
        const float mn = fmaxf(m, tmax), corr = __builtin_amdgcn_exp2f(m - mn); m = mn;
        float ps = 0.f;
#pragma unroll
        for (int x = 0; x < 16; ++x) { const float p = __builtin_amdgcn_exp2f(a16[x] - mn); a16[x] = p; ps += p; }
        lsum = lsum * corr + ps;
        bf16x8 P[2];
#pragma unroll
        for (int s2 = 0; s2 < 2; ++s2) { u32x4 w;
#pragma unroll
            for (int j = 0; j < 4; ++j) w[j] = pk2(a16[8 * s2 + 2 * j], a16[8 * s2 + 2 * j + 1]);
            P[s2] = __builtin_bit_cast(bf16x8, w); }
#pragma unroll
        for (int dt = 0; dt < NDT; ++dt) {
#pragma unroll
            for (int x = 0; x < 16; ++x) O[dt][x] *= corr;
#pragma unroll
            for (int s2 = 0; s2 < 2; ++s2) { const LAS unsigned char* vp = Vt + (32 * dt + r) * vstride + (key0 + 32 * i + 16 * s2 + 4 * h) * 2;
                const s16x4 lo = *(const LAS s16x4*)vp, hi = *(const LAS s16x4*)(vp + 16);
                const bf16x8 a = __builtin_shufflevector(lo, hi, 0, 1, 2, 3, 4, 5, 6, 7);
                O[dt] = __builtin_amdgcn_mfma_f32_32x32x16_bf16(a, P[s2], O[dt], 0, 0, 0); } }
    }
    lsum += __shfl_xor(lsum, 32);
    if (SWA) lsum += __builtin_amdgcn_exp2f(sink2 - m);
    const float inv = 1.0f / lsum;
#pragma unroll
    for (int dt = 0; dt < NDT; ++dt)
#pragma unroll
        for (int g4 = 0; g4 < 4; ++g4) { u32x2 w; w.x = pk2(O[dt][4 * g4] * inv, O[dt][4 * g4 + 1] * inv); w.y = pk2(O[dt][4 * g4 + 2] * inv, O[dt][4 * g4 + 3] * inv); *(u32x2*)(optr + 32 * dt + 8 * g4 + 4 * h) = w; }
}
constexpr int SW_KS = 144, SW_VS = 776, SW_VOFF = 384 * SW_KS;
constexpr int MA_KS = 272, MA_VS = 520, MA_VOFF = 256 * MA_KS;
DI void swa_unit(const Frame& F_, int l, int u) {
    const Frame F = refresh(F_);
    const int kvh = u & 1, qblk = (u >> 1) & 127, b = u >> 8;
    const bf16_t* PROJ = WSP(bf16_t, WS_PROJ);
    const int kt0 = (qblk - 1) * 128;
    LAS unsigned char* Ks = F.lds; LAS unsigned char* Vt = F.lds + SW_VOFF; const f32x4* RT = WSP(f32x4, WS_ROPE);
#pragma unroll 2
    for (int it = 0; it < 6; ++it) { const int ch = F.tid + it * 512, key = ch >> 3, qq = ch & 7, tpos = kt0 + key; const bool valid = (tpos >= 0) && (tpos < SEQ);
        const bf16_t* src = PROJ + (size_t)(b * SEQ + (valid ? tpos : 0)) * PJ + kvh * 64 + 8 * qq;
        u32x4 kv = {0u, 0u, 0u, 0u}, vv = {0u, 0u, 0u, 0u}; if (valid) { kv = *(const u32x4*)(src + C_K); vv = *(const u32x4*)(src + C_V); }
        { u32x4 oth;
#pragma unroll
          for (int j = 0; j < 4; ++j) oth[j] = (unsigned)__shfl_xor((int)kv[j], 1);
          if (qq < 2 && valid) { const f32x4* rt = RT + (size_t)tpos * 4;
#pragma unroll
              for (int j = 0; j < 4; ++j) { const f32x4 cs = rt[j]; const float m0 = bflo(kv[j]), m1 = bfhi(kv[j]), o0 = bflo(oth[j]), o1 = bfhi(oth[j]);
                  kv[j] = qq ? pk2(m0 * cs[0] + o0 * cs[1], m1 * cs[2] + o1 * cs[3]) : pk2(m0 * cs[0] - o0 * cs[1], m1 * cs[2] - o1 * cs[3]); } } }
        *(LAS u32x4*)(Ks + key * SW_KS + 16 * qq) = kv;
#pragma unroll
        for (int j = 0; j < 4; ++j) { *(LAS unsigned short*)(Vt + (8 * qq + 2 * j) * SW_VS + key * 2) = (unsigned short)(vv[j] & 0xffffu); *(LAS unsigned short*)(Vt + (8 * qq + 2 * j + 1) * SW_VS + key * 2) = (unsigned short)(vv[j] >> 16); } }
    __syncthreads();
#pragma unroll 1
    for (int i2 = 0; i2 < 2; ++i2) { const int sb = F.wave * 2 + i2, g = sb >> 2, q32 = sb & 3, head = kvh * 4 + g;
        const int qtok = b * SEQ + qblk * 128 + q32 * 32 + (F.lane & 31);
        attn_sub<9, 4, 2, true>(Ks, SW_KS, Vt, SW_VS, q32 * 32, PROJ + (size_t)qtok * PJ + C_Q + head * 64, WSP(bf16_t, WS_YSW) + (size_t)qtok * 512 + head * 64,
                                0.125f, inp(F, 15)[l * 8 + head], kt0 + q32 * 32, F.lane, RT + (size_t)(qblk * 128 + q32 * 32 + (F.lane & 31)) * 4); }
    __syncthreads();
}
DI void mema_unit(const Frame& F_, int l, int u) {
    const Frame F = refresh(F_);
    const int head = u & 3, qc = (u >> 2) & 31, b = u >> 7;
    const bf16_t* PROJ = WSP(bf16_t, WS_PROJ); const bf16_t* MK = WSP(bf16_t, WS_MK) + (size_t)l * 512 * 512; const bf16_t* MVT = WSP(bf16_t, WS_MVT) + (size_t)l * 512 * 512;
    LAS unsigned char* Ks = F.lds; LAS unsigned char* Vt = F.lds + MA_VOFF;
#pragma unroll 2
    for (int it = 0; it < 8; ++it) { const int ch = F.tid + it * 512; { const int key = ch >> 4, qq = ch & 15; *(LAS u32x4*)(Ks + key * MA_KS + 16 * qq) = *(const u32x4*)(MK + (size_t)(b * 256 + key) * 512 + head * 128 + 8 * qq); }
        { const int d = ch >> 5, qq = ch & 31; const u32x4 v = *(const u32x4*)(MVT + (size_t)(head * 128 + d) * 512 + b * 256 + 8 * qq); LAS u32x2* dst = (LAS u32x2*)(Vt + d * MA_VS + 16 * qq); dst[0] = (u32x2){v.x, v.y}; dst[1] = (u32x2){v.z, v.w}; } }
    __syncthreads();
#pragma unroll 1
    for (int i2 = 0; i2 < 2; ++i2) { const int qtok = b * SEQ + qc * 512 + F.wave * 64 + i2 * 32 + (F.lane & 31);
        attn_sub<8, 8, 4, false>(Ks, MA_KS, Vt, MA_VS, 0, PROJ + (size_t)qtok * PJ + C_MQ + head * 128, WSP(bf16_t, WS_YMEM) + (size_t)qtok * 512 + head * 128, 0.08838834764831845f, 0.f, 0, F.lane); }
    __syncthreads();
}

DI void phase_conv_rope(const Frame& F_, int l) {
    const Frame F = refresh(F_);
    const int gt = F.bid * 512 + F.tid, NT = F.G * 512;
    { const bf16_t* ZT = WSP(bf16_t, WS_ZT); float* ZC = WSP(float, WS_ZC); const float* cw = inp(F, 6) + (size_t)l * 3 * 1536; const float* cb = inp(F, 7) + l * 1536;
      for (int idx = gt; idx < 1536 * 4096; idx += NT) { const int c = idx >> 12, tok0 = (idx & 4095) * 8; const bf16_t* zr = ZT + (size_t)c * NTOK + tok0;
          const u32x4 v = *(const u32x4*)zr;
          const float prev = ((tok0 & (SEQ - 1)) == 0) ? 0.f : bflo((unsigned)zr[-1]), next = (((tok0 + 8) & (SEQ - 1)) == 0) ? 0.f : bflo((unsigned)zr[8]);
          const float w0 = cw[c], w1 = cw[1536 + c], w2 = cw[3072 + c], bb = cb[c];
          float z[10]; z[0] = prev; z[9] = next;
#pragma unroll
          for (int j = 0; j < 4; ++j) { z[1 + 2 * j] = bflo(v[j]); z[2 + 2 * j] = bfhi(v[j]); }
          f32x4 o0, o1;
#pragma unroll
          for (int j = 0; j < 4; ++j) { o0[j] = w0 * z[j] + w1 * z[j + 1] + w2 * z[j + 2] + bb; o1[j] = w0 * z[j + 4] + w1 * z[j + 5] + w2 * z[j + 6] + bb; }
          float* op = ZC + (size_t)c * NTOK + tok0; *(f32x4*)op = o0; *(f32x4*)(op + 4) = o1; } }
    bf16_t* PROJ = WSP(bf16_t, WS_PROJ); const f32x4* RT = WSP(f32x4, WS_ROPE);
    for (int idx = gt; idx < NTOK * 10; idx += NT) { const int tok = idx / 10, hh = idx - tok * 10, pos = tok & (SEQ - 1);
        bf16_t* p = PROJ + (size_t)tok * PJ + (hh < 8 ? C_Q + hh * 64 : C_K + (hh - 8) * 64);
        const u32x4 x1 = *(const u32x4*)p, x2 = *(const u32x4*)(p + 8); u32x4 y1, y2;
#pragma unroll
        for (int j = 0; j < 4; ++j) { const f32x4 cs = RT[pos * 4 + j];
            const float a0 = bflo(x1[j]), a1 = bfhi(x1[j]), b0 = bflo(x2[j]), b1 = bfhi(x2[j]);
            y1[j] = pk2(a0 * cs[0] - b0 * cs[1], a1 * cs[2] - b1 * cs[3]); y2[j] = pk2(b0 * cs[0] + a0 * cs[1], b1 * cs[2] + a1 * cs[3]); }
        *(u32x4*)p = y1; *(u32x4*)(p + 8) = y2; }
}
DI void phase_tr_y2(const Frame& F_) {
    const Frame F = refresh(F_);
    const int gw = F.bid * 8 + F.wave, NGW = F.G * 8, lane = F.lane;
    LAS float* scr = (LAS float*)(F.lds + F.wave * 16640);
    for (int it = gw; it < 8 * 512; it += NGW) { const int ct = it & 7, tt = it >> 3, c0 = ct * 64, tok0 = tt * 64;
        const bf16_t* src = WSP(bf16_t, WS_Y2) + (size_t)c0 * NTOK + tok0 + lane;
#pragma unroll 8
        for (int ch = 0; ch < 64; ++ch) scr[ch * 65 + lane] = bflo((unsigned)src[(size_t)ch * NTOK]);
        LDS_WAIT();
        const int kc = lane & 7;
#pragma unroll
        for (int i = 0; i < 8; ++i) { const int tk = 8 * i + (lane >> 3); const LAS float* s = scr + (8 * kc) * 65 + tk;
            u32x4 o; o.x = pk2(s[0], s[65]); o.y = pk2(s[2 * 65], s[3 * 65]); o.z = pk2(s[4 * 65], s[5 * 65]); o.w = pk2(s[6 * 65], s[7 * 65]);
            *(u32x4*)(WSP(bf16_t, WS_YHY) + (size_t)(tok0 + tk) * 512 + c0 + 8 * kc) = o; }
        LDS_WAIT(); }
}

DI void phase_ln1_router(const Frame& F_, int l) {
    const Frame F = refresh(F_);
    LAS float* lg = (LAS float*)F.lds + F.wave * 512;
    volatile LAS int* cnt = (volatile LAS int*)(F.MISC + 16);
    const bf16_t* RWB = WSP(bf16_t, WS_RW) + (size_t)l * 2 * 32 * 1024;
    const float* rb = inp(F, 24) + l * 32; const float* g1 = inp(F, 21) + l * DM; const float* b1 = inp(F, 22) + l * DM;
    const int lane = F.lane, rr = lane & 15, g = lane >> 4;
    for (int chunk = F.bid; chunk < NCHUNK; chunk += F.G) {
        if (F.tid < 32) cnt[F.tid] = 0;
        __syncthreads();
        const int row = chunk * CHUNK + F.wave * 16 + rr;
        const bf16_t* xr = WSP(bf16_t, WS_R) + (size_t)row * DM + 8 * g;
        float s1 = 0.f, s2 = 0.f;
#pragma unroll 4
        for (int s = 0; s < 32; ++s) { const u32x4 rw_ = *(const u32x4*)(xr + 32 * s); const f32x4 a = {bflo(rw_.x), bfhi(rw_.x), bflo(rw_.y), bfhi(rw_.y)}, b = {bflo(rw_.z), bfhi(rw_.z), bflo(rw_.w), bfhi(rw_.w)};
            s1 += (a[0] + a[1]) + (a[2] + a[3]) + (b[0] + b[1]) + (b[2] + b[3]);
            s2 += (a[0] * a[0] + a[1] * a[1]) + (a[2] * a[2] + a[3] * a[3]) + (b[0] * b[0] + b[1] * b[1]) + (b[2] * b[2] + b[3] * b[3]); }
        s1 += __shfl_xor(s1, 16); s1 += __shfl_xor(s1, 32); s2 += __shfl_xor(s2, 16); s2 += __shfl_xor(s2, 32);
        const float mean = s1 * (1.f / DM), rstd = 1.f / sqrtf(fmaxf(s2 * (1.f / DM) - mean * mean, 0.f) + LN_EPS);
        f32x4 acc0 = {0.f, 0.f, 0.f, 0.f}, acc1 = {0.f, 0.f, 0.f, 0.f};
        bf16_t* x1o = WSP(bf16_t, WS_X1) + (size_t)row * DM + 8 * g; unsigned char* x8o = WSP(unsigned char, WS_X1B) + (size_t)row * DM + 8 * g;
        const bf16_t* w0 = RWB + (size_t)rr * 1024 + 8 * g;
#pragma unroll 2
        for (int s = 0; s < 32; ++s) { const int k0 = 32 * s;
            const u32x4 rw_ = *(const u32x4*)(xr + k0); f32x4 a = {bflo(rw_.x), bfhi(rw_.x), bflo(rw_.y), bfhi(rw_.y)}, b = {bflo(rw_.z), bfhi(rw_.z), bflo(rw_.w), bfhi(rw_.w)};
            const f32x4 ga = *(const f32x4*)(g1 + 8 * g + k0), gb = *(const f32x4*)(g1 + 8 * g + k0 + 4), ba = *(const f32x4*)(b1 + 8 * g + k0), bb = *(const f32x4*)(b1 + 8 * g + k0 + 4);
            a = (a - mean) * rstd * ga + ba; b = (b - mean) * rstd * gb + bb;
            { u32x2 w8; w8.x = pk4f8(a[0] * 16.0f, a[1] * 16.0f, a[2] * 16.0f, a[3] * 16.0f); w8.y = pk4f8(b[0] * 16.0f, b[1] * 16.0f, b[2] * 16.0f, b[3] * 16.0f); *(u32x2*)(x8o + k0) = w8; }
            u32x4 hi, lo;
            hi.x = pk2(a[0], a[1]); hi.y = pk2(a[2], a[3]); hi.z = pk2(b[0], b[1]); hi.w = pk2(b[2], b[3]);
            *(u32x4*)(x1o + k0) = hi;
            lo.x = pk2(a[0] - bflo(hi.x), a[1] - bfhi(hi.x)); lo.y = pk2(a[2] - bflo(hi.y), a[3] - bfhi(hi.y)); lo.z = pk2(b[0] - bflo(hi.z), b[1] - bfhi(hi.z)); lo.w = pk2(b[2] - bflo(hi.w), b[3] - bfhi(hi.w));
            const bf16x8 xh = __builtin_bit_cast(bf16x8, hi), xl = __builtin_bit_cast(bf16x8, lo);
            const bf16x8 wh0 = *(const bf16x8*)(w0 + k0), wh1 = *(const bf16x8*)(w0 + 16 * 1024 + k0), wl0 = *(const bf16x8*)(w0 + 32 * 1024 + k0), wl1 = *(const bf16x8*)(w0 + 48 * 1024 + k0);
            acc0 = __builtin_amdgcn_mfma_f32_16x16x32_bf16(xh, wh0, acc0, 0, 0, 0); acc0 = __builtin_amdgcn_mfma_f32_16x16x32_bf16(xl, wh0, acc0, 0, 0, 0); acc0 = __builtin_amdgcn_mfma_f32_16x16x32_bf16(xh, wl0, acc0, 0, 0, 0);
            acc1 = __builtin_amdgcn_mfma_f32_16x16x32_bf16(xh, wh1, acc1, 0, 0, 0); acc1 = __builtin_amdgcn_mfma_f32_16x16x32_bf16(xl, wh1, acc1, 0, 0, 0); acc1 = __builtin_amdgcn_mfma_f32_16x16x32_bf16(xh, wl1, acc1, 0, 0, 0); }
        { const float rb0 = rb[rr], rb1 = rb[16 + rr];
#pragma unroll
          for (int i = 0; i < 4; ++i) { lg[(4 * g + i) * 32 + rr] = acc0[i] + rb0; lg[(4 * g + i) * 32 + 16 + rr] = acc1[i] + rb1; } }
        LDS_WAIT();
        if (lane < 16) { const int row2 = chunk * CHUNK + F.wave * 16 + lane;
            float v0 = -3e38f, v1 = -3e38f, v2 = -3e38f, v3 = -3e38f; int i0 = 0, i1 = 0, i2 = 0, i3 = 0;
            for (int e = 0; e < 32; ++e) { const float x = lg[lane * 32 + e];
                if (x > v0) { v3 = v2; i3 = i2; v2 = v1; i2 = i1; v1 = v0; i1 = i0; v0 = x; i0 = e; }
                else if (x > v1) { v3 = v2; i3 = i2; v2 = v1; i2 = i1; v1 = x; i1 = e; }
                else if (x > v2) { v3 = v2; i3 = i2; v2 = x; i2 = e; }
                else if (x > v3) { v3 = x; i3 = e; } }
            const float e1 = __expf(v1 - v0), e2 = __expf(v2 - v0), e3 = __expf(v3 - v0), inv = 1.0f / (1.0f + e1 + e2 + e3);
            *(int4*)(WSP(int, WS_ROUTE + RT_E) + (size_t)row2 * 4) = make_int4(i0, i1, i2, i3);
            *(f32x4*)(WSP(float, WS_ROUTE + RT_G) + (size_t)row2 * 4) = (f32x4){inv, e1 * inv, e2 * inv, e3 * inv};
            LDS_ADD1(cnt + i0); LDS_ADD1(cnt + i1); LDS_ADD1(cnt + i2); LDS_ADD1(cnt + i3); }
        LDS_WAIT();
        __syncthreads();
        if (F.tid < 32) WSP(int, WS_ROUTE + RT_BLKCNT)[chunk * 32 + F.tid] = cnt[F.tid];
        __syncthreads();
    }
}
DI void phase_route(const Frame& F_) {
    const Frame F = refresh(F_);
    LAS int* pt = (LAS int*)F.lds;
    LAS int* tot = pt + 512;
    LAS int* est = tot + 32;
    LAS int* basel = est + 40;
    LAS int* ea = basel + 32;
    const int* BC = WSP(int, WS_ROUTE + RT_BLKCNT);
    { const int e = F.tid & 31, gq = F.tid >> 5; int s = 0; for (int c = gq * 16; c < gq * 16 + 16; ++c) s += BC[c * 32 + e]; pt[gq * 32 + e] = s; }
    __syncthreads();
    if (F.tid < 32) { int s = 0; for (int q = 0; q < 16; ++q) s += pt[q * 32 + F.tid]; tot[F.tid] = s; }
    __syncthreads();
    if (F.tid == 0) { int s = 0; for (int e = 0; e < 32; ++e) { est[e] = s; s += (tot[e] + 255) & ~255; } est[32] = s; }
    __syncthreads();
    int* SLOT = WSP(int, WS_ROUTE + RT_SLOT);
    if (F.bid == 0) {
        for (int e = 0; e < 32; ++e) { const int s0 = est[e] + tot[e], s1 = est[e + 1]; for (int p = s0 + F.tid; p < s1; p += 512) SLOT[p] = 0;
            for (int t = (est[e] >> 8) + F.tid; t < (est[e + 1] >> 8); t += 512) WSP(int, WS_ROUTE + RT_TILE)[t] = e; }
        if (F.tid == 0) WSP(int, WS_ROUTE + RT_NT)[0] = est[32] >> 8;
    }
    for (int chunk = F.bid; chunk < NCHUNK; chunk += F.G) {
        if (F.tid < 32) { const int e = F.tid, gq = chunk >> 4; int s = est[e]; for (int q = 0; q < gq; ++q) s += pt[q * 32 + e]; for (int c = gq * 16; c < chunk; ++c) s += BC[c * 32 + e]; basel[e] = s; }
        const int a = F.tid, row = chunk * CHUNK + (a >> 2); const int my = WSP(int, WS_ROUTE + RT_E)[(size_t)row * 4 + (a & 3)];
        ea[a] = my;
        __syncthreads();
        int rank = 0; for (int q = 0; q < a; ++q) rank += (ea[q] == my) ? 1 : 0;
        const int pos = basel[my] + rank;
        WSP(int, WS_ROUTE + RT_POS)[(size_t)row * 4 + (a & 3)] = pos; SLOT[pos] = row;
        __syncthreads();
    }
}
DI void phase_combine_ln2(const Frame& F_, int l) {
    const Frame F = refresh(F_);
    const int gw = F.bid * 8 + F.wave, NGW = F.G * 8, lane = F.lane;
    const float* g2 = inp(F, 29) + l * DM; const float* b2 = inp(F, 30) + l * DM; const unsigned char* YB = WSP(unsigned char, WS_YBUF);
    for (int m = gw; m < NTOK; m += NGW) {
        const int4 pos = *(const int4*)(WSP(int, WS_ROUTE + RT_POS) + (size_t)m * 4); const f32x4 gt = *(const f32x4*)(WSP(float, WS_ROUTE + RT_G) + (size_t)m * 4);
        const int pp[4] = {pos.x, pos.y, pos.z, pos.w};
        f32x4 v[4];
#pragma unroll
        for (int j = 0; j < 4; ++j) { const u32x2 xw = *(const u32x2*)(WSP(bf16_t, WS_X1) + (size_t)m * DM + 4 * lane + 256 * j); v[j] = (f32x4){bflo(xw.x), bfhi(xw.x), bflo(xw.y), bfhi(xw.y)} * ALPHA; }
#pragma unroll
        for (int k = 0; k < 4; ++k) { const unsigned char* yr = YB + (size_t)pp[k] * DM + 4 * lane; const float gk = gt[k] * (1.0f / 64.0f);
#pragma unroll
            for (int j = 0; j < 4; ++j) { const int w = *(const int*)(yr + 256 * j); const f32x2 lo = __builtin_amdgcn_cvt_pk_f32_fp8(w, false), hi = __builtin_amdgcn_cvt_pk_f32_fp8(w, true);
                v[j][0] += gk * lo.x; v[j][1] += gk * lo.y; v[j][2] += gk * hi.x; v[j][3] += gk * hi.y; } }
        ln_rowv(v, g2, b2, lane);
        if (l == DEPTH - 1) store_row_f32(F.out + (size_t)m * DM, v, lane);
        else { store_row_bf16(WSP(bf16_t, WS_XB) + (size_t)m * DM, v, lane); store_row_f8(WSP(unsigned char, WS_X8) + (size_t)m * DM, v, lane, 16.0f); }
    }
}

#define IN(k) (lo <= (k) && (k) < hi)
#define GRIDBAR() do { XcdBarrier bar_; bar_.bar = (unsigned*)((unsigned char*)lds_u64(F0.MISC + 60) + WS_CTL) + CW_BAR; bar_.x = xb_xcc_id(); bar_.st = F0.MISC + 8; xcd_barrier(bar_); } while (0)
#define SEAM(k) do { if (IN(k) && IN((k) + 1)) { XcdBarrier bar_; bar_.bar = (unsigned*)((unsigned char*)lds_u64(F0.MISC + 60) + WS_CTL) + CW_BAR; bar_.x = xb_xcc_id(); bar_.st = F0.MISC + 8; xcd_barrier(bar_); } } while (0)
template <int l> DI void ph_gemm_in(const Frame& F0) { const Frame F = refresh(F0);
            { constexpr size_t TS = (size_t)256 * 1024 * 2;
              static_assert(WS_XB % TS == 0 && WS_WIN % TS == 0, "operand tiles");
              pg8::Gemm g{WSP(bf16_t, 0), WSP(bf16_t, 0), 1024, nullptr}; pg8::InOrder S; S.T.init(NTOK / 256, 5, F.G, F.bid); S.G = F.G; S.c = F.bid; S.l = l; S.tA = (int)(WS_XB / TS); S.tW = (int)(WS_WIN / TS);
              pg8::EpiIn E{WSP(bf16_t, WS_PROJ), WSP(bf16_t, WS_ZT), 1.0f};
              pg8::gemm_phase<pg8::EpiIn, pg8::InOrder, false>(F.lds, g, S, E, F.wave); }
            { constexpr size_t TS = (size_t)256 * 1024;
              static_assert(WS_X8 % TS == 0 && WS_WG8 % TS == 0, "operand tiles");
              pg8::Gemm g{WSP(bf16_t, 0), WSP(bf16_t, 0), 1024, nullptr}; pg8::GateOrder S; S.init(NTOK / 256, 12, F.G, F.bid); S.l = l; S.tA = (int)(WS_X8 / TS); S.tW = (int)(WS_WG8 / TS);
              pg8::EpiGL8 E{WSP(unsigned char, WS_ZC), 16.0f / 1024.0f};
              pg8::gemm_phase<pg8::EpiGL8, pg8::GateOrder, true, true>(F.lds, g, S, E, F.wave); }
        }
template <int l> DI void ph_conv_rope(const Frame& F0) { phase_conv_rope(F0, l); }
template <int l> DI void ph_mix(const Frame& F0) {
            const int G = gridDim.x, bid = blockIdx.x;
            if (EN(13)) for (int c = bid; c < 512; c += G) hyena_unit(F0, l, c);
            if (EN(14)) for (int u = bid; u < 512; u += G) swa_unit(F0, l, u);
            if (EN(15)) for (int u = bid; u < 256; u += G) mema_unit(F0, l, u);
            if ((DUP_MASK >> 14) & 1u) { __syncthreads(); for (int u = bid; u < 512; u += G) swa_unit(F0, l, u); }
            if ((DUP_MASK >> 15) & 1u) { __syncthreads(); for (int u = bid; u < 256; u += G) mema_unit(F0, l, u); }
        }
template <int l> DI void ph_tr_y2(const Frame& F0) { phase_tr_y2(F0); }
template <int l> DI void ph_branch(const Frame& F0) { const Frame F = refresh(F0);
            static_assert(WS_YSW == WS_YHY + 32 * MiB && WS_YMEM == WS_YSW + 32 * MiB, "branch activations are three consecutive [NTOK][512] buffers");
            pg8::Gemm g{WSP(bf16_t, WS_YHY), WSP(bf16_t, WS_WBR), 512, nullptr}; pg8::BranchOrder S; S.init(NTOK / 256, 4, F.G, F.bid); S.l = l;
            pg8::EpiGate E{WSP(unsigned char, WS_ZC), inp(F, 5) + (size_t)l * 3 * 1024, WSP(bf16_t, WS_MERGED)};
            pg8::gemm_phase<pg8::EpiGate, pg8::BranchOrder, false>(F.lds, g, S, E, F.wave);
        }
template <int l> DI void ph_out(const Frame& F0) { const Frame F = refresh(F0);
            pg8::Gemm g{WSP(bf16_t, WS_MERGED), WSP(bf16_t, WS_WOUT) + (size_t)l * 1024 * 1024, 1024, nullptr}; pg8::StaticOrder S; S.init(NTOK / 256, 4, F.G, F.bid);
            pg8::EpiRes E{WSP(bf16_t, WS_XB), WSP(bf16_t, WS_R)};
            pg8::gemm_phase<pg8::EpiRes, pg8::StaticOrder, false>(F.lds, g, S, E, F.wave);
        }
template <int l> DI void ph_ln1(const Frame& F0) { phase_ln1_router(F0, l); }
template <int l> DI void ph_route(const Frame& F0) { phase_route(F0); }
template <int l> DI void ph_moe_up(const Frame& F0) { const Frame F = refresh(F0);
            const int ntile = __builtin_amdgcn_readfirstlane(WSP(int, WS_ROUTE + RT_NT)[0]);
            pg8::Gemm g{WSP(bf16_t, WS_X1B), (const bf16_t*)(WSP(unsigned char, WS_W1) + (size_t)l * 32 * 2048 * 1024), 1024, WSP(int, WS_ROUTE + RT_SLOT), F.lds + 131072, inp(F, 26) + (size_t)l * 32 * 2048, 2048};
            { LAS int* lt = (LAS int*)(F.lds + 131072 + 4096); for (int i = F.tid; i < ntile; i += 512) lt[i] = WSP(int, WS_ROUTE + RT_TILE)[i]; __syncthreads(); }
            pg8::GroupOrderL S; S.init(ntile, 8, F.G, F.bid); S.tile_e = (const LAS int*)(F.lds + 131072 + 4096);
            pg8::EpiSwiglu E{WSP(unsigned char, WS_ACT), inp(F, 26) + (size_t)l * 32 * 2048, 1.0f / 1024.0f};
            pg8::gemm_phase<pg8::EpiSwiglu, pg8::GroupOrderL, true, true, true>(F.lds, g, S, E, F.wave);
        }
template <int l> DI void ph_moe_down(const Frame& F0) { const Frame F = refresh(F0);
            const int ntile = __builtin_amdgcn_readfirstlane(WSP(int, WS_ROUTE + RT_NT)[0]);
            pg8::Gemm g{WSP(bf16_t, WS_ACT), (const bf16_t*)(WSP(unsigned char, WS_W2) + (size_t)l * 32 * 1024 * 1024), 1024, WSP(int, WS_ROUTE + RT_IOTA), F.lds + 131072, inp(F, 28) + (size_t)l * 32 * 1024, 1024};
            { LAS int* lt = (LAS int*)(F.lds + 131072 + 4096); for (int i = F.tid; i < ntile; i += 512) lt[i] = WSP(int, WS_ROUTE + RT_TILE)[i]; __syncthreads(); }
            pg8::GroupOrderL S; S.init(ntile, 4, F.G, F.bid); S.tile_e = (const LAS int*)(F.lds + 131072 + 4096);
            pg8::EpiBf16 E{WSP(bf16_t, WS_YBUF), DM, 0, inp(F, 28) + (size_t)l * 32 * 1024, 1024, 1.0f / 1024.0f, 1};
            pg8::gemm_phase<pg8::EpiBf16, pg8::GroupOrderL, true, true, true>(F.lds, g, S, E, F.wave);
        }
template <int l> DI void ph_ln2(const Frame& F0) { phase_combine_ln2(F0, l); }
template <int l> DI void layer_body(const Frame& F0, const int lo, const int hi) {
        constexpr int pb = 2 + l * NPH_LAYER;
        if (EN(2) && IN(pb + 0)) { ph_gemm_in<l>(F0); if ((DUP_MASK >> 2) & 1u) { GRIDBAR(); ph_gemm_in<l>(F0); } }
        SEAM(pb + 0);
        if (EN(4) && IN(pb + 2)) { ph_mix<l>(F0); if ((DUP_MASK >> 4) & 1u) { GRIDBAR(); ph_mix<l>(F0); } }
        SEAM(pb + 2);
        if (EN(5) && IN(pb + 3)) { ph_tr_y2<l>(F0); if ((DUP_MASK >> 5) & 1u) { GRIDBAR(); ph_tr_y2<l>(F0); } }
        SEAM(pb + 3);
        if (EN(6) && IN(pb + 4)) { ph_branch<l>(F0); if ((DUP_MASK >> 6) & 1u) { GRIDBAR(); ph_branch<l>(F0); } }
        SEAM(pb + 4);
        if (EN(7) && IN(pb + 5)) { ph_out<l>(F0); if ((DUP_MASK >> 7) & 1u) { GRIDBAR(); ph_out<l>(F0); } }
        SEAM(pb + 5);
        if (EN(8) && IN(pb + 6)) { ph_ln1<l>(F0); if ((DUP_MASK >> 8) & 1u) { GRIDBAR(); ph_ln1<l>(F0); } }
        SEAM(pb + 6);
        if (EN(9) && IN(pb + 7)) { ph_route<l>(F0); if ((DUP_MASK >> 9) & 1u) { GRIDBAR(); ph_route<l>(F0); } }
        SEAM(pb + 7);
        if (EN(10) && IN(pb + 8)) { ph_moe_up<l>(F0); if ((DUP_MASK >> 10) & 1u) { GRIDBAR(); ph_moe_up<l>(F0); } }
        SEAM(pb + 8);
        if (EN(11) && IN(pb + 9)) { ph_moe_down<l>(F0); if ((DUP_MASK >> 11) & 1u) { GRIDBAR(); ph_moe_down<l>(F0); } }
        SEAM(pb + 9);
        if (EN(12) && IN(pb + 10)) { ph_ln2<l>(F0); if ((DUP_MASK >> 12) & 1u) { GRIDBAR(); ph_ln2<l>(F0); } }
        SEAM(pb + 10);
    }
struct Args { const float* in[31]; float* out; unsigned char* ws; int ph_lo, ph_hi; };
__global__ void __launch_bounds__(512, 2) mega_fwd(Args args) {
    extern __shared__ __attribute__((aligned(16))) unsigned char lds_raw[];
    Frame F0;
#define F F0
    F.lds = (LAS unsigned char*)lds_raw; F.MISC = (volatile LAS unsigned*)(F.lds + MISC_OFF);
    F.tid = threadIdx.x; F.lane = F.tid & 63; F.wave = __builtin_amdgcn_readfirstlane(F.tid >> 6); F.G = gridDim.x; F.bid = blockIdx.x;
    F.out = args.out; F.ws = args.ws;
    if (F.tid < 60) F.MISC[F.tid] = 0u;
    if (F.tid == 65) { const unsigned long long w = (unsigned long long)args.ws, o = (unsigned long long)args.out; F.MISC[60] = (unsigned)w; F.MISC[61] = (unsigned)(w >> 32); F.MISC[62] = (unsigned)o; F.MISC[63] = (unsigned)(o >> 32); }
    if (F.tid == 64) {
#pragma unroll
        for (int i = 0; i < 31; ++i) { const unsigned long long p = (unsigned long long)args.in[i]; F.MISC[64 + 2 * i] = (unsigned)p; F.MISC[64 + 2 * i + 1] = (unsigned)(p >> 32); } }
    __syncthreads();
    if (!MK_PER_PHASE) (void)xcd_barrier_post(WSP(unsigned, WS_CTL) + CW_BAR, F.MISC + 8);
#undef F
    const int lo = args.ph_lo, hi = args.ph_hi;
    F0.out = nullptr; F0.ws = nullptr; F0.tid = 0; F0.lane = 0;

    if (EN(0) && IN(0)) REP(0) { REPBAR(); phase_proA(F0); }
    SEAM(0);
    if (EN(1) && IN(1)) REP(1) { REPBAR(); const Frame F = refresh(F0);
        if (EN(19)) { pg8::Gemm g{WSP(bf16_t, WS_FW), WSP(bf16_t, WS_FH), 256, nullptr}; pg8::BatchOrder S{4, 8, 64, 8, 0, 64, 0, F.G, F.bid}; pg8::EpiWin E{WSP(_Float16, WS_HF)};
          pg8::gemm_phase<pg8::EpiWin, pg8::BatchOrder, false>(F.lds, g, S, E, F.wave); }
        if (EN(20)) { pg8::Gemm g{WSP(bf16_t, WS_MEMB), WSP(bf16_t, WS_WKV), 1024, nullptr}; pg8::BatchOrder S{4, 2, 2, 0, 0, 4, 0, F.G, F.bid}; pg8::EpiBf16 E{WSP(bf16_t, WS_MK), 512, (size_t)512 * 512, nullptr, 0};
          pg8::gemm_phase<pg8::EpiBf16, pg8::BatchOrder, false>(F.lds, g, S, E, F.wave); }
        if (EN(21)) { pg8::Gemm g{WSP(bf16_t, WS_WKV), WSP(bf16_t, WS_MEMB), 1024, nullptr}; pg8::BatchOrder S{4, 2, 2, 4, 2, 0, 0, F.G, F.bid}; pg8::EpiBf16 E{WSP(bf16_t, WS_MVT), 512, (size_t)512 * 512, nullptr, 0};
          pg8::gemm_phase<pg8::EpiBf16, pg8::BatchOrder, false>(F.lds, g, S, E, F.wave); }
    }
    SEAM(1);
    layer_body<0>(F0, lo, hi); layer_body<1>(F0, lo, hi); layer_body<2>(F0, lo, hi); layer_body<3>(F0, lo, hi);
#undef IN
#undef SEAM
}

extern "C" void kernel_launch(void* const* d_in, const int* in_sizes, int n_in, void* d_out, int out_size, void* d_ws, size_t ws_size, hipStream_t stream) {
    static int grid = 0;
    if (grid == 0) {
        if (n_in != 31 || out_size != NTOK * DM || ws_size < WS_END) { fprintf(stderr, "kernel_launch: unexpected shapes (n_in %d out %d ws %zu)\n", n_in, out_size, ws_size); grid = -1; return; }
        int dev = 0, cus = 0, per_cu = 0;
        if (hipGetDevice(&dev) != hipSuccess || hipDeviceGetAttribute(&cus, hipDeviceAttributeMultiprocessorCount, dev) != hipSuccess) { grid = -1; return; }
        if (hipFuncSetAttribute((const void*)mega_fwd, hipFuncAttributeMaxDynamicSharedMemorySize, LDS_BYTES) != hipSuccess) { fprintf(stderr, "kernel_launch: hipFuncSetAttribute failed\n"); grid = -1; return; }
        if (hipOccupancyMaxActiveBlocksPerMultiprocessor(&per_cu, (const void*)mega_fwd, 512, LDS_BYTES) != hipSuccess || per_cu < 1) { fprintf(stderr, "kernel_launch: occupancy query says %d\n", per_cu); }
        (void)hipGetLastError();
        grid = cus < 256 ? cus : 256;
    }
    if (grid < 0) return;
    (void)hipMemsetAsync((char*)d_ws + WS_CTL, 0, CTL_ZERO_BYTES, stream);
    Args a{};
    for (int i = 0; i < 31; ++i) a.in[i] = (const float*)d_in[i];
    a.out = (float*)d_out; a.ws = (unsigned char*)d_ws;
#if MK_PER_PHASE
    for (int p = 0; p < NPHASES; ++p) { a.ph_lo = p; a.ph_hi = p + 1; hipLaunchKernelGGL(mega_fwd, dim3(grid), dim3(512), LDS_BYTES, stream, a); }
#else
    a.ph_lo = 0; a.ph_hi = NPHASES;
    hipLaunchKernelGGL(mega_fwd, dim3(grid), dim3(512), LDS_BYTES, stream, a);
#endif
}
```

```cpp
#include <hip/hip_runtime.h>
#include <cstdio>
#include <cstdint>

#ifndef MK_PER_PHASE
#define MK_PER_PHASE 0
#endif

#ifndef PH_MASK
#define PH_MASK 0xFFFFFFFFu
#endif
#define EN(b) ((PH_MASK >> (b)) & 1u)
#ifndef DUP_MASK
#define DUP_MASK 0u
#endif
#define REP(b) for (int rep_ = 0; rep_ < (((DUP_MASK >> (b)) & 1u) ? 2 : 1); ++rep_)
#define REPBAR() do { if (rep_) { GRIDBAR(); } } while (0)
#define DI __device__ __forceinline__
#define LAS __attribute__((address_space(3)))
#define GAS __attribute__((address_space(1)))
typedef unsigned short bf16_t;
typedef short bf16x8 __attribute__((ext_vector_type(8)));
typedef short s16x4 __attribute__((ext_vector_type(4)));
typedef float f32x2 __attribute__((ext_vector_type(2)));
typedef float f32x4 __attribute__((ext_vector_type(4)));
typedef float f32x16 __attribute__((ext_vector_type(16)));
typedef unsigned u32x2 __attribute__((ext_vector_type(2)));
typedef unsigned u32x4 __attribute__((ext_vector_type(4)));
typedef __bf16 bf16v2 __attribute__((ext_vector_type(2)));

DI unsigned pk2(float lo, float hi) { f32x2 v = {lo, hi}; return __builtin_bit_cast(unsigned, __builtin_convertvector(v, bf16v2)); }
DI float bflo(unsigned w) { return __uint_as_float(w << 16); }
DI float bfhi(unsigned w) { return __uint_as_float(w & 0xffff0000u); }
typedef _Float16 h16x2 __attribute__((ext_vector_type(2)));
DI unsigned pkh(float a, float b) { f32x2 v = {a, b}; return __builtin_bit_cast(unsigned, __builtin_convertvector(v, h16x2)); }
DI f32x2 unh(unsigned w) { return __builtin_convertvector(__builtin_bit_cast(h16x2, w), f32x2); }
typedef int v8i __attribute__((ext_vector_type(8)));
DI float clamp8(float x) { return __builtin_amdgcn_fmed3f(x, -448.0f, 448.0f); }
DI unsigned pk4f8(float a, float b, float c, float d) { a = clamp8(a); b = clamp8(b); c = clamp8(c); d = clamp8(d); int w = 0; w = __builtin_amdgcn_cvt_pk_fp8_f32(a, b, w, false); w = __builtin_amdgcn_cvt_pk_fp8_f32(c, d, w, true); return (unsigned)w; }
DI float bf1(float x) { return bflo(pk2(x, 0.f) & 0xffffu); }

constexpr int NTOK = 32768, DM = 1024, SEQ = 16384, NBATCH = 2, DEPTH = 4;
constexpr int INC = 5888;
constexpr int PJ = 4352, C_Q = 0, C_K = 512, C_V = 640, C_MQ = 768, C_GL = 1280;
constexpr int NEXP = 32, MAXTILES = 544, PMAX = MAXTILES * 256;
constexpr int NCHUNK = 256, CHUNK = 128;
constexpr float LN_EPS = 1e-5f, ALPHA = 1.681792830507429f;
constexpr int NPH_LAYER = 11, NPHASES = 2 + DEPTH * NPH_LAYER;

constexpr size_t MiB = 1u << 20;
constexpr size_t WS_CTL = 0, CTL_ZERO_BYTES = 1 * MiB;
constexpr size_t WS_ROUTE = 1 * MiB;
constexpr size_t RT_E = 0, RT_G = 512 * 1024, RT_POS = 1024 * 1024, RT_BLKCNT = 1536 * 1024, RT_SLOT = 1600 * 1024, RT_TILE = 2200 * 1024, RT_NT = 2208 * 1024, RT_IOTA = 2304 * 1024;
constexpr size_t WS_X8 = (134 + 256) * MiB, WS_WG8 = (134 + 256 + 32) * MiB;
constexpr size_t WS_ROPE = 51 * MiB;
constexpr size_t WS_MEMB = 5 * MiB, WS_MK = 6 * MiB, WS_MVT = 10 * MiB, WS_FH = 14 * MiB, WS_FW = 46 * MiB, WS_RW = 50 * MiB;
constexpr size_t WS_WIN = 52 * MiB, WS_WKV = 98 * MiB, WS_WBR = 114 * MiB, WS_WOUT = 126 * MiB, WS_W1 = 134 * MiB, WS_W2 = 646 * MiB;
constexpr size_t WS_HF = 902 * MiB, WS_XB = 1414 * MiB, WS_PROJ = 1478 * MiB, WS_ZT = 1750 * MiB, WS_ZC = 1846 * MiB, WS_Y2 = 2038 * MiB;
constexpr size_t WS_YHY = 2102 * MiB, WS_YSW = 2134 * MiB, WS_YMEM = 2166 * MiB, WS_MERGED = 2198 * MiB, WS_R = 2262 * MiB;
constexpr size_t WS_X1 = 2390 * MiB, WS_X1B = 2518 * MiB, WS_ACT = 2582 * MiB, WS_YBUF = 2854 * MiB, WS_FFTS = 3126 * MiB, WS_END = 3318 * MiB;
constexpr int CW_BAR = 4096;

constexpr int SCR_BYTES = 139264;
constexpr int MISC_OFF = SCR_BYTES;
constexpr int LDS_BYTES = 147456;

#define XB_TMO      128
#define XB_XCNT(j)  (256  + 64 * (j))
#define XB_XSUB(j)  (1280 + 64 * (j))
#define XB_XGEN(j)  (2304 + 64 * (j))
#define XB_TOP      3328
#define XB_TOPGEN   3392
#define XCD_BAR_WORDS 3456
#define XB_SPIN_CAP (1u << 18)
__device__ __forceinline__ unsigned xb_ld(unsigned* p)              { return __hip_atomic_load(p, __ATOMIC_RELAXED, __HIP_MEMORY_SCOPE_AGENT); }
__device__ __forceinline__ unsigned xb_add(unsigned* p, unsigned v) { return __hip_atomic_fetch_add(p, v, __ATOMIC_RELAXED, __HIP_MEMORY_SCOPE_AGENT); }
__device__ __forceinline__ unsigned xb_xcc_id() { return (unsigned)__builtin_amdgcn_s_getreg((3 << 11) | 20) & 0xFu; }
#define XB_SPIN(cond, bar) do { unsigned _sp = 0; while (cond) { __builtin_amdgcn_s_sleep(1); \
    if ((++_sp & 255u) == 0u) { if (xb_ld(&(bar)[XB_TMO])) break; if (_sp > XB_SPIN_CAP) { atomicAdd(&(bar)[XB_TMO], 1u); break; } } } } while (0)
struct XcdBarrier { unsigned* bar; unsigned x; volatile LAS unsigned* st; };
__device__ __forceinline__ XcdBarrier xcd_barrier_post(unsigned* bar, volatile LAS unsigned* st) {
    XcdBarrier b; b.bar = bar; b.x = xb_xcc_id(); b.st = st;
    if (threadIdx.x == 0) (void)xb_add(&bar[XB_XCNT(b.x)], 1u);
    return b;
}
__device__ __forceinline__ void xcd_barrier_complete(unsigned* bar, unsigned x, unsigned& nloc, unsigned& nx) {
    const unsigned G = gridDim.x * gridDim.y * gridDim.z;
    unsigned sum, cnt, mine, sp = 0u;
    for (;;) {
        sum = 0u; cnt = 0u; mine = 0u;
#pragma unroll
        for (unsigned j = 0; j < 16; ++j) { const unsigned c = xb_ld(&bar[XB_XCNT(j)]); sum += c; cnt += (c > 0u) ? 1u : 0u; mine = (j == x) ? c : mine; }
        if (sum == G) break;
        __builtin_amdgcn_s_sleep(1);
        if ((++sp & 255u) == 0u) { if (xb_ld(&bar[XB_TMO])) break; if (sp > XB_SPIN_CAP) { atomicAdd(&bar[XB_TMO], 1u); break; } }
    }
    nloc = mine > 0u ? mine : 1u; nx = cnt > 0u ? cnt : 1u;
}
__device__ __forceinline__ void xcd_barrier(const XcdBarrier& b) {
    asm volatile("s_waitcnt vmcnt(0)" ::: "memory");
    __syncthreads();
    if (threadIdx.x == 0) {
        unsigned* bar = b.bar;
        __builtin_amdgcn_s_waitcnt(0);
        unsigned nloc = b.st[0], nx = b.st[1];
        if (nloc == 0u) { xcd_barrier_complete(bar, b.x, nloc, nx); b.st[0] = nloc; b.st[1] = nx; }
        const unsigned old = xb_add(&bar[XB_XSUB(b.x)], 1u);
        const unsigned gen = old / nloc;
        if (old + 1u == (gen + 1u) * nloc) {
            __builtin_amdgcn_fence(__ATOMIC_RELEASE, "agent");
            asm volatile("s_waitcnt vmcnt(0)" ::: "memory");
            const unsigned og = xb_add(&bar[XB_TOP], 1u);
            const unsigned tg = og / nx;
            if (og + 1u == (tg + 1u) * nx) xb_add(&bar[XB_TOPGEN], 1u);
            else XB_SPIN(xb_ld(&bar[XB_TOPGEN]) == tg, bar);
            __builtin_amdgcn_fence(__ATOMIC_ACQUIRE, "agent");
            xb_add(&bar[XB_XGEN(b.x)], 1u);
            asm volatile("s_waitcnt vmcnt(0)" ::: "memory");
        } else {
            XB_SPIN(xb_ld(&bar[XB_XGEN(b.x)]) == gen, bar);
            __builtin_amdgcn_fence(__ATOMIC_ACQUIRE, "agent");
            asm volatile("s_waitcnt vmcnt(0)" ::: "memory");
        }
    }
    __syncthreads();
}

namespace pg8 {
constexpr int BM = 256, BK = 64, HALF = 128, HTB = HALF * BK * 2, STAGE_BYTES = 8 * HTB, NXCD = 8, WGM = 8;
DI int lds_byte(int r, int c) { const int st = (r >> 4) * 2 + (c >> 5), rr = r & 15, cc = c & 31, ob = rr * 64 + cc * 2; return st * 1024 + (ob ^ (((ob >> 9) & 1) << 5)); }
DI void stage_rc(int b, int& R, int& C) { const int st = b / 1024, sb = b % 1024, swz = sb ^ (((sb >> 9) & 1) << 5); R = (st >> 1) * 16 + swz / 64; C = (st & 1) * 32 + (swz % 64) / 2; }
DI int perm32(int rho) { const int n = rho >> 4, i = rho & 15; return 8 * (i >> 2) + 4 * n + (i & 3); }

struct Unit { int am, bm, om, on, e; };
struct Gemm { const bf16_t* A; const bf16_t* Bt; int K; const int* gather; LAS unsigned char* aux = nullptr; const float* pbias = nullptr; int pbstride = 0; };

struct TileOrder {
    int nM, nN, nwg, G, c;
    DI void init(int nM_, int nN_, int G_, int c_) { nM = nM_; nN = nN_; nwg = nM * nN; G = G_; c = c_; }
    DI bool tile(int i, int& pm, int& pn) const { return tileL((long)i * G + c, pm, pn); }
    DI bool tileL(long L, int& pm, int& pn) const {
        if (L >= nwg) return false;
        int wgid = (int)L; { const int q = nwg / NXCD, r = nwg % NXCD, xcd = wgid % NXCD, off = wgid / NXCD; wgid = (xcd < r ? xcd * (q + 1) : r * (q + 1) + (xcd - r) * q) + off; }
        const int nig = WGM * nN, gid = wgid / nig, fm = gid * WGM, gsz = (nM - fm) < WGM ? (nM - fm) : WGM;
        pm = fm + ((wgid % nig) % gsz); pn = (wgid % nig) / gsz; return true;
    }
};
struct StaticOrder : TileOrder { DI bool next(int i, Unit& u) const { int pm, pn; if (!tile(i, pm, pn)) return false; u.am = pm; u.bm = pn; u.om = pm; u.on = pn; u.e = 0; return true; } };
struct GroupOrder : TileOrder { const int* tile_e;
    DI bool next(int i, Unit& u) const { int pm, pn; if (!tile(i, pm, pn)) return false; const int e = __builtin_amdgcn_readfirstlane(tile_e[pm]); u.am = pm; u.bm = e * nN + pn; u.om = pm; u.on = pn; u.e = e; return true; } };
struct GroupOrderL : TileOrder { const LAS int* tile_e;
    DI bool next(int i, Unit& u) const { int pm, pn; if (!tile(i, pm, pn)) return false; const int e = __builtin_amdgcn_readfirstlane(tile_e[pm]); u.am = pm; u.bm = e * nN + pn; u.om = pm; u.on = pn; u.e = e; return true; } };
struct BatchOrder { int nL, nM, nN, amL, am0, bmL, bm0, G, c;
    DI bool next(int i, Unit& u) const { const int L = i * G + c; if (L >= nL * nM * nN) return false; const int l = L / (nM * nN), r = L % (nM * nN), pm = r % nM, pn = r / nM;
        u.am = l * amL + am0 + pm; u.bm = l * bmL + bm0 + pn; u.om = pm; u.on = pn; u.e = l; return true; } };

struct EpiBf16 {
    static constexpr bool PERM = true;
    bf16_t* O; int ldc; size_t estride; const float* bias; int bstride; float scale = 1.0f; int f8out = 0;
    DI void operator()(const f32x4 (&acc)[2][2][4][2], const Unit& u, int wr, int wc, int fr, int fq, const LAS float* lb = nullptr) const {
        const int row0 = u.om * BM + wr * 64 + fr, col0 = u.on * BM + wc * 32 + 8 * fq; bf16_t* base = O + (size_t)u.e * estride;
        f32x4 bv[2][2];
#pragma unroll
        for (int bj = 0; bj < 2; ++bj)
#pragma unroll
            for (int n = 0; n < 2; ++n) bv[bj][n] = lb ? *(const LAS f32x4*)(lb + wc * 32 + 8 * fq + bj * HALF + 4 * n) : (bias ? *(const f32x4*)(bias + (size_t)u.e * bstride + col0 + bj * HALF + 4 * n) : (f32x4){0.f, 0.f, 0.f, 0.f});
#pragma unroll
        for (int ai = 0; ai < 2; ++ai)
#pragma unroll
            for (int m = 0; m < 4; ++m) { bf16_t* rowp = base + (size_t)(row0 + ai * HALF + m * 16) * ldc + col0;
#pragma unroll
                for (int bj = 0; bj < 2; ++bj) { const f32x4 v0 = acc[ai][bj][m][0] * scale + bv[bj][0], v1 = acc[ai][bj][m][1] * scale + bv[bj][1];
                    if (f8out) { u32x2 w8; w8.x = pk4f8(v0[0] * 64.0f, v0[1] * 64.0f, v0[2] * 64.0f, v0[3] * 64.0f); w8.y = pk4f8(v1[0] * 64.0f, v1[1] * 64.0f, v1[2] * 64.0f, v1[3] * 64.0f);
                        *(u32x2*)((unsigned char*)base + (size_t)(row0 + ai * HALF + m * 16) * ldc + col0 + bj * HALF) = w8; }
                    else { u32x4 w; w.x = pk2(v0[0], v0[1]); w.y = pk2(v0[2], v0[3]); w.z = pk2(v1[0], v1[1]); w.w = pk2(v1[2], v1[3]);
                        *(u32x4*)(rowp + bj * HALF) = w; } } }
    }
};
struct EpiWin {
    static constexpr bool PERM = false;
    _Float16* O;
    DI void operator()(const f32x4 (&acc)[2][2][4][2], const Unit& u, int wr, int wc, int fr, int fq) const {
        const int row0 = u.om * BM + wr * 64 + fr, col0 = u.on * BM + wc * 32 + 4 * fq; _Float16* base = O + (size_t)u.e * 2048 * SEQ;
#pragma unroll
        for (int ai = 0; ai < 2; ++ai)
#pragma unroll
            for (int m = 0; m < 4; ++m) { _Float16* rowp = base + (size_t)(row0 + ai * HALF + m * 16) * SEQ + col0;
#pragma unroll
                for (int bj = 0; bj < 2; ++bj)
#pragma unroll
                    for (int n = 0; n < 2; ++n) { const f32x4 v = acc[ai][bj][m][n] * 256.0f; u32x2 w; w.x = pkh(v[0], v[1]); w.y = pkh(v[2], v[3]); *(u32x2*)(rowp + bj * HALF + n * 16) = w; } }
    }
};
struct EpiRes {
    static constexpr bool PERM = true;
    const bf16_t* X; bf16_t* R;
    DI void operator()(const f32x4 (&acc)[2][2][4][2], const Unit& u, int wr, int wc, int fr, int fq) const {
        const int row0 = u.om * BM + wr * 64 + fr, col0 = u.on * BM + wc * 32 + 8 * fq;
#pragma unroll
        for (int ai = 0; ai < 2; ++ai)
#pragma unroll
            for (int m = 0; m < 4; ++m) { const size_t off = (size_t)(row0 + ai * HALF + m * 16) * DM + col0;
#pragma unroll
                for (int bj = 0; bj < 2; ++bj) { const u32x4 xv = *(const u32x4*)(X + off + bj * HALF); const f32x4 a0 = acc[ai][bj][m][0], a1 = acc[ai][bj][m][1];
                    u32x4 w; w.x = pk2(bflo(xv.x) * ALPHA + a0[0], bfhi(xv.x) * ALPHA + a0[1]); w.y = pk2(bflo(xv.y) * ALPHA + a0[2], bfhi(xv.y) * ALPHA + a0[3]);
                    w.z = pk2(bflo(xv.z) * ALPHA + a1[0], bfhi(xv.z) * ALPHA + a1[1]); w.w = pk2(bflo(xv.w) * ALPHA + a1[2], bfhi(xv.w) * ALPHA + a1[3]);
                    *(u32x4*)(R + off + bj * HALF) = w; } }
    }
};
struct EpiGate {
    static constexpr bool PERM = true;
    const unsigned char* gl0; const float* bg0; bf16_t* O;
    DI void operator()(const f32x4 (&acc)[2][2][4][2], const Unit& u, int wr, int wc, int fr, int fq) const {
        const int row0 = u.om * BM + wr * 64 + fr, col0 = u.on * BM + wc * 32 + 8 * fq; const unsigned char* gl = gl0 + u.e * 1024; const float* bg = bg0 + u.e * 1024; const bool first = (u.e == 0);
        f32x4 bv[2][2];
#pragma unroll
        for (int bj = 0; bj < 2; ++bj)
#pragma unroll
            for (int n = 0; n < 2; ++n) bv[bj][n] = *(const f32x4*)(bg + col0 + bj * HALF + 4 * n);
#pragma unroll
        for (int ai = 0; ai < 2; ++ai)
#pragma unroll
            for (int m = 0; m < 4; ++m) { const int row = row0 + ai * HALF + m * 16;
#pragma unroll
                for (int bj = 0; bj < 2; ++bj) { const int col = col0 + bj * HALF;
                    const u32x2 gw = *(const u32x2*)(gl + (size_t)row * 3072 + col);
                    u32x4 old = {0u, 0u, 0u, 0u}; if (!first) old = *(const u32x4*)(O + (size_t)row * DM + col);
                    float r[8];
#pragma unroll
                    for (int j = 0; j < 4; ++j) { const unsigned o2 = old[j]; const f32x2 g2 = (j & 1) ? __builtin_amdgcn_cvt_pk_f32_fp8((int)gw[j >> 1], true) : __builtin_amdgcn_cvt_pk_f32_fp8((int)gw[j >> 1], false);
                        const float a0 = g2.x * (1.0f / 16.0f) + bv[bj][j >> 1][(j & 1) * 2], a1 = g2.y * (1.0f / 16.0f) + bv[bj][j >> 1][(j & 1) * 2 + 1];
                        const float s0 = __builtin_amdgcn_rcpf(1.0f + __builtin_amdgcn_exp2f(-1.4426950408889634f * a0)), s1 = __builtin_amdgcn_rcpf(1.0f + __builtin_amdgcn_exp2f(-1.4426950408889634f * a1));
                        r[2 * j] = bflo(o2) + s0 * acc[ai][bj][m][j >> 1][(j & 1) * 2]; r[2 * j + 1] = bfhi(o2) + s1 * acc[ai][bj][m][j >> 1][(j & 1) * 2 + 1]; }
                    u32x4 w; w.x = pk2(r[0], r[1]); w.y = pk2(r[2], r[3]); w.z = pk2(r[4], r[5]); w.w = pk2(r[6], r[7]);
                    *(u32x4*)(O + (size_t)row * DM + col) = w; } }
    }
};
struct EpiSwiglu {
    static constexpr bool PERM = true;
    unsigned char* O; const float* bias; float ascale;
    DI void operator()(const f32x4 (&acc)[2][2][4][2], const Unit& u, int wr, int wc, int fr, int fq, const LAS float* lb = nullptr) const {
        const int row0 = u.om * BM + wr * 64 + fr, col0 = u.on * BM + wc * 32 + 8 * fq;
        f32x4 bv[2][2];
#pragma unroll
        for (int bj = 0; bj < 2; ++bj)
#pragma unroll
            for (int n = 0; n < 2; ++n) bv[bj][n] = lb ? *(const LAS f32x4*)(lb + wc * 32 + 8 * fq + bj * HALF + 4 * n) : *(const f32x4*)(bias + (size_t)u.e * 2048 + col0 + bj * HALF + 4 * n);
#pragma unroll
        for (int ai = 0; ai < 2; ++ai)
#pragma unroll
            for (int m = 0; m < 4; ++m) { unsigned char* rowp = O + (size_t)(row0 + ai * HALF + m * 16) * DM + (col0 >> 1);
#pragma unroll
                for (int bj = 0; bj < 2; ++bj) { const f32x4 v0 = acc[ai][bj][m][0] * ascale + bv[bj][0], v1 = acc[ai][bj][m][1] * ascale + bv[bj][1];
                    float o[4];
#pragma unroll
                    for (int j = 0; j < 4; ++j) { float gl_ = (j < 2) ? v0[2 * j] : v1[2 * j - 4], ln_ = (j < 2) ? v0[2 * j + 1] : v1[2 * j - 3];
                        gl_ = fminf(gl_, 7.0f); ln_ = fminf(fmaxf(ln_, -7.0f), 7.0f);
                        o[j] = 8.0f * gl_ * __builtin_amdgcn_rcpf(1.0f + __builtin_amdgcn_exp2f(-1.702f * 1.4426950408889634f * gl_)) * (ln_ + 1.0f); }
                    *(unsigned*)(rowp + bj * (HALF / 2)) = pk4f8(o[0], o[1], o[2], o[3]); } }
    }
};
struct BranchOrder : TileOrder { int l;
    DI bool next(int i, Unit& u) const { int pm, pn; const int t = i / 3, br = i - 3 * t; if (!tile(t, pm, pn)) return false; u.am = br * 128 + pm; u.bm = (br * 4 + l) * 4 + pn; u.om = pm; u.on = pn; u.e = br; return true; } };
struct InOrder { TileOrder T; int G, c, l, tA, tW;
    DI bool next(int i, Unit& u) const { const int L = i * G + c; if (L >= 1408) return false;
        if (L < 640) { int pm, pn; T.tile(i, pm, pn); u.am = tA + pm; u.bm = tW + l * 23 + 6 + pn; u.om = pm; u.on = pn; u.e = 1; }
        else { const int r = L - 640, pw = r % 6, pt = r / 6; u.am = tW + l * 23 + pw; u.bm = tA + pt; u.om = pw; u.on = pt; u.e = 0; }
        return true; } };
struct GateOrder : TileOrder { int l, tA, tW;
    DI bool next(int i, Unit& u) const { int pm, pn; long L;
        if (G == 256) { if (i < 5) L = (long)i * 256 + c; else if (c >= 128 && i < 7) L = 1280 + (long)(i - 5) * 128 + (c - 128); else return false; }
        else L = (long)i * G + c;
        if (!tileL(L, pm, pn)) return false; u.am = tA + pm; u.bm = tW + l * 12 + pn; u.om = pm; u.on = 5 + pn; u.e = 1; return true; } };
struct EpiGL8 {
    static constexpr bool PERM = true;
    unsigned char* O; float scale;
    DI void operator()(const f32x4 (&acc)[2][2][4][2], const Unit& u, int wr, int wc, int fr, int fq) const {
        const int row0 = u.om * BM + wr * 64 + fr, col0 = (u.on - 5) * BM + wc * 32 + 8 * fq;
#pragma unroll
        for (int ai = 0; ai < 2; ++ai)
#pragma unroll
            for (int m = 0; m < 4; ++m) { unsigned char* rowp = O + (size_t)(row0 + ai * HALF + m * 16) * 3072 + col0;
#pragma unroll
                for (int bj = 0; bj < 2; ++bj) { const f32x4 v0 = acc[ai][bj][m][0] * scale, v1 = acc[ai][bj][m][1] * scale;
                    u32x2 w; w.x = pk4f8(v0[0], v0[1], v0[2], v0[3]); w.y = pk4f8(v1[0], v1[1], v1[2], v1[3]); *(u32x2*)(rowp + bj * HALF) = w; } }
    }
};
struct EpiIn {
    static constexpr bool PERM = true;
    bf16_t* P; bf16_t* Z; float scale;
    DI void operator()(const f32x4 (&acc)[2][2][4][2], const Unit& u, int wr, int wc, int fr, int fq) const {
        const int row0 = u.om * BM + wr * 64 + fr, col0 = u.on * BM + wc * 32 + 8 * fq; bf16_t* base = u.e ? P : Z; const int ldc = u.e ? PJ : NTOK;
#pragma unroll
        for (int ai = 0; ai < 2; ++ai)
#pragma unroll
            for (int m = 0; m < 4; ++m) { bf16_t* rowp = base + (size_t)(row0 + ai * HALF + m * 16) * ldc + col0;
#pragma unroll
                for (int bj = 0; bj < 2; ++bj) { const f32x4 v0 = acc[ai][bj][m][0] * scale, v1 = acc[ai][bj][m][1] * scale;
                    u32x4 w; w.x = pk2(v0[0], v0[1]); w.y = pk2(v0[2], v0[3]); w.z = pk2(v1[0], v1[1]); w.w = pk2(v1[2], v1[3]);
                    *(u32x4*)(rowp + bj * HALF) = w; } }
    }
};
template <class Epi, class Sched, bool GATHER, bool FP8 = false, bool PREF = false>
DI void gemm_phase(LAS unsigned char* lds, const Gemm g, const Sched& S, const Epi& E, int wave_id) {
    unsigned z_o = 0u; asm volatile("" : "+v"(z_o));
    int tid_o = wave_id * 64 + (int)__builtin_amdgcn_mbcnt_hi(~0u, __builtin_amdgcn_mbcnt_lo(~0u, z_o)); asm volatile("" : "+v"(tid_o));
    const int tid = tid_o, wid = __builtin_amdgcn_readfirstlane(tid >> 6), lane = tid & 63, wr = wid >> 2, wc = wid & 3, fr = lane & 15, fq = lane >> 4;
    const int K = g.K, RB = FP8 ? K : 2 * K, nt = RB / 128;
    unsigned voffA[2], voffB[2];
#pragma unroll
    for (int i = 0; i < 2; ++i) { int R, C; stage_rc(tid * 16 + i * 8192, R, C); const int Rb = Epi::PERM ? ((R & ~31) + perm32(R & 31)) : R;
        voffA[i] = (unsigned)(R * RB + 2 * C); voffB[i] = (unsigned)(Rb * RB + 2 * C); }
    const size_t kstep = (size_t)(BK * 2);
    const size_t hstep = (size_t)HALF * RB;
    const size_t tstep = 2 * hstep;
    const unsigned ldsw = (unsigned)wid * 1024u;
    const int aoff = lds_byte(wr * 64 + fr, fq * 8), boff = lds_byte(wc * 32 + fr, fq * 8);
#define PG8_SA(b, h) (((b) * 2 + (h)) * HTB)
#define PG8_SB(b, h) ((4 + (b) * 2 + (h)) * HTB)
#define PG8_STAGE(bufoff, gbase, voff) do { _Pragma("unroll") for (int _i = 0; _i < 2; ++_i) \
        __builtin_amdgcn_global_load_lds((const unsigned*)((const char*)(gbase) + (voff)[_i]), (LAS unsigned*)(lds + (bufoff) + ldsw + _i * 8192), 16, 0, 0); } while (0)
#define PG8_STAGE_A(bufoff, kb, h, vg) do { if constexpr (GATHER) { PG8_STAGE(bufoff, kb, (vg)[h]); } else { PG8_STAGE(bufoff, (kb) + (h) * hstep, voffA); } } while (0)
#define PG8_LDA(dst, b, h) do { if constexpr (FP8) { _Pragma("unroll") for (int m = 0; m < 4; ++m) dst##8[m] = PG8_LD8(lds + PG8_SA(b, h) + aoff + m * 2048); } \
        else { _Pragma("unroll") for (int m = 0; m < 4; ++m) _Pragma("unroll") for (int k = 0; k < 2; ++k) dst[m][k] = *(const LAS bf16x8*)(lds + PG8_SA(b, h) + aoff + m * 2048 + k * 1024); } } while (0)
#define PG8_LDB(dst, b, h) do { if constexpr (FP8) { _Pragma("unroll") for (int n = 0; n < 2; ++n) dst##8[n] = PG8_LD8(lds + PG8_SB(b, h) + boff + n * 2048); } \
        else { _Pragma("unroll") for (int n = 0; n < 2; ++n) _Pragma("unroll") for (int k = 0; k < 2; ++k) dst[n][k] = *(const LAS bf16x8*)(lds + PG8_SB(b, h) + boff + n * 2048 + k * 1024); } } while (0)
#define PG8_LD8(p) __builtin_shufflevector(*(const LAS u32x4*)(p), *(const LAS u32x4*)((p) + 1024), 0, 1, 2, 3, 4, 5, 6, 7)
#define PG8_MMA(ai, bj, At, Bt) do { __builtin_amdgcn_s_setprio(1); _Pragma("unroll") for (int m = 0; m < 4; ++m) _Pragma("unroll") for (int n = 0; n < 2; ++n) { \
        if constexpr (FP8) acc[ai][bj][m][n] = __builtin_amdgcn_mfma_scale_f32_16x16x128_f8f6f4(__builtin_bit_cast(v8i, Bt##8[n]), __builtin_bit_cast(v8i, At##8[m]), acc[ai][bj][m][n], 0, 0, 0, 0x7F7F7F7F, 0, 0x7F7F7F7F); \
        else { _Pragma("unroll") for (int k = 0; k < 2; ++k) acc[ai][bj][m][n] = __builtin_amdgcn_mfma_f32_16x16x32_bf16(Bt[n][k], At[m][k], acc[ai][bj][m][n], 0, 0, 0); } } \
        __builtin_amdgcn_s_setprio(0); } while (0)
#define PG8_WAIT_V(n) asm volatile("s_waitcnt vmcnt(" #n ")" ::: "memory")
#define PG8_WAIT_L(n) asm volatile("s_waitcnt lgkmcnt(" #n ")" ::: "memory")
#define PG8_BAR __builtin_amdgcn_s_barrier()
#define PG8_SCHED __builtin_amdgcn_sched_barrier(0)
#define PG8_GATHER(vg, unit) do { _Pragma("unroll") for (int _i = 0; _i < 2; ++_i) { int _R, _C; stage_rc(tid * 16 + _i * 8192, _R, _C); _Pragma("unroll") for (int _h = 0; _h < 2; ++_h) \
        { const int _row = (unit).am * BM + _h * HALF + _R; (vg)[_h][_i] = (unsigned)(g.gather ? g.gather[_row] : _row) * (unsigned)RB + (unsigned)_C * 2u; } } } while (0)
#define PG8_PREF(unit, par) do { if (wid < 4) __builtin_amdgcn_global_load_lds((const unsigned*)(g.gather + (unit).am * BM + wid * 64 + lane), (LAS unsigned*)(g.aux + (par) * 1024 + wid * 256), 4, 0, 0); \
        else __builtin_amdgcn_global_load_lds((const unsigned*)(g.pbias + (size_t)(unit).e * g.pbstride + (unit).on * BM + (wid - 4) * 64 + lane), (LAS unsigned*)(g.aux + 2048 + (par) * 1024 + (wid - 4) * 256), 4, 0, 0); } while (0)
#define PG8_VG_LDS(vg, par) do { _Pragma("unroll") for (int _i = 0; _i < 2; ++_i) { int _R, _C; stage_rc(tid * 16 + _i * 8192, _R, _C); _Pragma("unroll") for (int _h = 0; _h < 2; ++_h) \
        (vg)[_h][_i] = (unsigned)((const LAS int*)(g.aux + (par) * 1024))[_h * HALF + _R] * (unsigned)RB + (unsigned)_C * 2u; } } while (0)
    Unit cur, nxt; int ui = 0;
    if (!S.next(0, cur)) return;
    f32x4 acc[2][2][4][2];
#pragma unroll
    for (int a = 0; a < 2; ++a)
#pragma unroll
        for (int b = 0; b < 2; ++b)
#pragma unroll
            for (int m = 0; m < 4; ++m)
#pragma unroll
                for (int n = 0; n < 2; ++n) acc[a][b][m][n] = (f32x4){0.f, 0.f, 0.f, 0.f};
    bf16x8 At[4][2], B0[2][2], B1[2][2];
    typedef unsigned u32x8 __attribute__((ext_vector_type(8)));
    u32x8 At8[4], B08[2], B18[2];
    unsigned vG[2][2] = {{0u, 0u}, {0u, 0u}}, vGn[2][2] = {{0u, 0u}, {0u, 0u}};
    const char* cA = (const char*)g.A + (GATHER ? (size_t)0 : (size_t)cur.am * tstep); const char* cB = (const char*)g.Bt + (size_t)cur.bm * tstep;
    if constexpr (PREF) { PG8_PREF(cur, 0); asm volatile("s_waitcnt vmcnt(0)" ::: "memory"); __builtin_amdgcn_s_barrier(); asm volatile("" ::: "memory"); PG8_VG_LDS(vG, 0); }
    else if constexpr (GATHER) { PG8_GATHER(vG, cur); }
    PG8_STAGE(PG8_SB(0, 0), cB, voffB); PG8_STAGE(PG8_SB(0, 1), cB + hstep, voffB); PG8_STAGE_A(PG8_SA(0, 0), cA, 0, vG); PG8_STAGE_A(PG8_SA(0, 1), cA, 1, vG);
    if (wr == 1) PG8_BAR;
    PG8_WAIT_V(2); PG8_BAR;
    PG8_STAGE(PG8_SB(1, 0), cB + kstep, voffB); PG8_STAGE_A(PG8_SA(1, 0), cA + kstep, 0, vG); PG8_STAGE(PG8_SB(1, 1), cB + hstep + kstep, voffB);
    PG8_WAIT_V(6); PG8_BAR;
    for (;;) {
        const bool has_next = S.next(ui + 1, nxt);
        const char* nA = has_next ? (const char*)g.A + (GATHER ? (size_t)0 : (size_t)nxt.am * tstep) : cA; const char* nB = has_next ? (const char*)g.Bt + (size_t)nxt.bm * tstep : cB;
        if constexpr (PREF) { if (has_next) PG8_PREF(nxt, (ui + 1) & 1); }
        else if constexpr (GATHER) { if (has_next) { PG8_GATHER(vGn, nxt); } else {
#pragma unroll
            for (int _h = 0; _h < 2; ++_h)
#pragma unroll
                for (int _i = 0; _i < 2; ++_i) vGn[_h][_i] = vG[_h][_i]; } }
#pragma unroll 1
        for (int t = 0; t < nt; t += 2) {
            const bool last = (t == nt - 2);
            const char* a1 = cA + (size_t)(t + 1) * kstep;
            const char* a2 = last ? nA : cA + (size_t)(t + 2) * kstep; const char* b2 = last ? nB : cB + (size_t)(t + 2) * kstep;
            const char* a3 = a2 + kstep; const char* b3 = b2 + kstep;
            PG8_LDB(B0, 0, 0); PG8_LDB(B1, 0, 1); PG8_SCHED; PG8_LDA(At, 0, 0); PG8_STAGE_A(PG8_SA(1, 1), a1, 1, vG);
            if constexpr (PREF) { if (last && has_next) { PG8_VG_LDS(vG, (ui + 1) & 1); } }
            else if constexpr (GATHER) { if (last) {
#pragma unroll
                for (int _h = 0; _h < 2; ++_h)
#pragma unroll
                    for (int _i = 0; _i < 2; ++_i) vG[_h][_i] = vGn[_h][_i]; } }
            PG8_WAIT_V(8); PG8_WAIT_L(0); PG8_BAR; PG8_MMA(0, 0, At, B0); PG8_MMA(0, 1, At, B1); PG8_BAR; PG8_SCHED;
            PG8_LDA(At, 0, 1); PG8_STAGE(PG8_SB(0, 0), b2, voffB); PG8_STAGE(PG8_SB(0, 1), b2 + hstep, voffB); PG8_STAGE_A(PG8_SA(0, 0), a2, 0, vG);
            PG8_WAIT_V(8); PG8_WAIT_L(0); PG8_BAR; PG8_MMA(1, 0, At, B0); PG8_MMA(1, 1, At, B1); PG8_BAR; PG8_SCHED;
            PG8_LDB(B0, 1, 0); PG8_LDB(B1, 1, 1); PG8_SCHED; PG8_LDA(At, 1, 0); PG8_STAGE_A(PG8_SA(0, 1), a2, 1, vG);
            PG8_WAIT_V(8); PG8_WAIT_L(0); PG8_BAR; PG8_MMA(0, 0, At, B0); PG8_MMA(0, 1, At, B1); PG8_BAR; PG8_SCHED;
            PG8_LDA(At, 1, 1); PG8_STAGE(PG8_SB(1, 0), b3, voffB); PG8_STAGE(PG8_SB(1, 1), b3 + hstep, voffB); PG8_STAGE_A(PG8_SA(1, 0), a3, 0, vG);
            PG8_WAIT_V(8); PG8_WAIT_L(0); PG8_BAR; PG8_MMA(1, 0, At, B0); PG8_MMA(1, 1, At, B1); PG8_BAR; PG8_SCHED;
        }
        if (wr == 0) PG8_BAR;
        if constexpr (PREF) E(acc, cur, wr, wc, fr, fq, (const LAS float*)(g.aux + 2048 + (ui & 1) * 1024)); else E(acc, cur, wr, wc, fr, fq);
        if (!has_next) break;
#pragma unroll
        for (int a = 0; a < 2; ++a)
#pragma unroll
            for (int b = 0; b < 2; ++b)
#pragma unroll
                for (int m = 0; m < 4; ++m)
#pragma unroll
                    for (int n = 0; n < 2; ++n) acc[a][b][m][n] = (f32x4){0.f, 0.f, 0.f, 0.f};
        cur = nxt; cA = nA; cB = nB; ++ui;
        if (wr == 1) PG8_BAR;
    }
    PG8_WAIT_V(0);
    PG8_BAR;
#undef PG8_SA
#undef PG8_SB
#undef PG8_STAGE
#undef PG8_STAGE_A
#undef PG8_LDA
#undef PG8_LDB
#undef PG8_MMA
#undef PG8_LD8
#undef PG8_WAIT_V
#undef PG8_WAIT_L
#undef PG8_BAR
#undef PG8_SCHED
#undef PG8_GATHER
#undef PG8_PREF
#undef PG8_VG_LDS
}
}

struct Frame {
    LAS unsigned char* lds; volatile LAS unsigned* MISC;
    int tid, lane, wave, G, bid;
    float* out; unsigned char* ws;
};
DI const float* inp(const Frame& F, int k) { int z_ = 0; asm volatile("" : "+v"(z_)); volatile LAS unsigned* p = F.MISC + 64 + 2 * k + z_; const unsigned lo = __builtin_amdgcn_readfirstlane(p[0]), hi = __builtin_amdgcn_readfirstlane(p[1]); return (const float*)(const GAS float*)(((unsigned long long)hi << 32) | lo); }
DI unsigned long long lds_u64(volatile LAS unsigned* p0) { int z_ = 0; asm volatile("" : "+v"(z_)); volatile LAS unsigned* p = p0 + z_; const unsigned lo = __builtin_amdgcn_readfirstlane(p[0]), hi = __builtin_amdgcn_readfirstlane(p[1]); return ((unsigned long long)hi << 32) | lo; }
DI Frame refresh(const Frame& F0) { Frame F; F.lds = F0.lds; F.MISC = F0.MISC; F.wave = F0.wave; F.G = gridDim.x; F.bid = blockIdx.x;
    unsigned z_ = 0u; asm volatile("" : "+v"(z_));
    int t = F0.wave * 64 + (int)__builtin_amdgcn_mbcnt_hi(~0u, __builtin_amdgcn_mbcnt_lo(~0u, z_)); asm volatile("" : "+v"(t)); F.tid = t; F.lane = t & 63;
    F.ws = (unsigned char*)(GAS unsigned char*)lds_u64(F0.MISC + 60); F.out = (float*)(GAS float*)lds_u64(F0.MISC + 62); return F; }
#define WSP(T, off) ((T*)(F.ws + (off)))
DI float wave_sum(float v) {
#pragma unroll
    for (int o = 1; o < 64; o <<= 1) v += __shfl_xor(v, o);
    return v;
}
#define LDS_WAIT() asm volatile("s_waitcnt lgkmcnt(0)" ::: "memory")
#define LDS_ADD1(p) ((void)__hip_atomic_fetch_add((LAS int*)(p), 1, __ATOMIC_RELAXED, __HIP_MEMORY_SCOPE_WORKGROUP))

DI void tr_item(const float* W, int K, int N, bf16_t* WT, LAS float* scr, int item, int lane) {
    const int nblk = N >> 6, kb = item / nblk, nb = item - kb * nblk, k0 = kb << 6, n0 = nb << 6;
#pragma unroll 4
    for (int i = 0; i < 16; ++i) { const int kk = 4 * i + (lane >> 4); const f32x4 v = *(const f32x4*)(W + (size_t)(k0 + kk) * N + n0 + 4 * (lane & 15));
        LAS float* d = scr + kk * 65 + 4 * (lane & 15); d[0] = v[0]; d[1] = v[1]; d[2] = v[2]; d[3] = v[3]; }
    LDS_WAIT();
    const int kc = lane & 7;
#pragma unroll
    for (int it = 0; it < 8; ++it) { const int n = 8 * it + (lane >> 3); const LAS float* s = scr + (8 * kc) * 65 + n;
        u32x4 o; o.x = pk2(s[0], s[65]); o.y = pk2(s[2 * 65], s[3 * 65]); o.z = pk2(s[4 * 65], s[5 * 65]); o.w = pk2(s[6 * 65], s[7 * 65]);
        *(u32x4*)(WT + (size_t)(n0 + n) * K + k0 + 8 * kc) = o; }
    LDS_WAIT();
}
DI void tr_item8(const float* W, int K, int N, unsigned char* WT, float sc, LAS float* scr, int item, int lane) {
    const int nblk = N >> 6, kb = item / nblk, nb = item - kb * nblk, k0 = kb << 6, n0 = nb << 6;
#pragma unroll 4
    for (int i = 0; i < 16; ++i) { const int kk = 4 * i + (lane >> 4); const f32x4 v = *(const f32x4*)(W + (size_t)(k0 + kk) * N + n0 + 4 * (lane & 15));
        LAS float* d = scr + kk * 65 + 4 * (lane & 15); d[0] = v[0]; d[1] = v[1]; d[2] = v[2]; d[3] = v[3]; }
    LDS_WAIT();
    const int kc = lane & 7;
#pragma unroll
    for (int it = 0; it < 8; ++it) { const int n = 8 * it + (lane >> 3); const LAS float* s = scr + (8 * kc) * 65 + n;
        u32x2 o; o.x = pk4f8(s[0] * sc, s[65] * sc, s[2 * 65] * sc, s[3 * 65] * sc); o.y = pk4f8(s[4 * 65] * sc, s[5 * 65] * sc, s[6 * 65] * sc, s[7 * 65] * sc);
        *(u32x2*)(WT + (size_t)(n0 + n) * K + k0 + 8 * kc) = o; }
    LDS_WAIT();
}
DI void tr_item8g(const float* W, int K, int ldw, int NC, unsigned char* WT, float sc, LAS float* scr, int item, int lane) {
    const int nblk = NC >> 6, kb = item / nblk, nb = item - kb * nblk, k0 = kb << 6, n0 = nb << 6;
#pragma unroll 4
    for (int i = 0; i < 16; ++i) { const int kk = 4 * i + (lane >> 4); const f32x4 v = *(const f32x4*)(W + (size_t)(k0 + kk) * ldw + n0 + 4 * (lane & 15));
        LAS float* d = scr + kk * 65 + 4 * (lane & 15); d[0] = v[0]; d[1] = v[1]; d[2] = v[2]; d[3] = v[3]; }
    LDS_WAIT();
    const int kc = lane & 7;
#pragma unroll
    for (int it = 0; it < 8; ++it) { const int n = 8 * it + (lane >> 3); const LAS float* s = scr + (8 * kc) * 65 + n;
        u32x2 o; o.x = pk4f8(s[0] * sc, s[65] * sc, s[2 * 65] * sc, s[3 * 65] * sc); o.y = pk4f8(s[4 * 65] * sc, s[5 * 65] * sc, s[6 * 65] * sc, s[7 * 65] * sc);
        *(u32x2*)(WT + (size_t)(n0 + n) * K + k0 + 8 * kc) = o; }
    LDS_WAIT();
}
DI void ln_rowv(f32x4 (&v)[4], const float* g, const float* b, int lane) {
    float s = 0.f;
#pragma unroll
    for (int j = 0; j < 4; ++j) s += (v[j][0] + v[j][1]) + (v[j][2] + v[j][3]);
    const float mean = wave_sum(s) * (1.f / DM); float s2 = 0.f;
#pragma unroll
    for (int j = 0; j < 4; ++j) { v[j] = v[j] - mean; s2 += (v[j][0] * v[j][0] + v[j][1] * v[j][1]) + (v[j][2] * v[j][2] + v[j][3] * v[j][3]); }
    const float rstd = 1.f / sqrtf(wave_sum(s2) * (1.f / DM) + LN_EPS);
#pragma unroll
    for (int j = 0; j < 4; ++j) { const f32x4 gg = *(const f32x4*)(g + 4 * lane + 256 * j), bb = *(const f32x4*)(b + 4 * lane + 256 * j); v[j] = v[j] * rstd * gg + bb; }
}
DI void store_row_f32(float* row, const f32x4 (&v)[4], int lane) {
#pragma unroll
    for (int j = 0; j < 4; ++j) *(f32x4*)(row + 4 * lane + 256 * j) = v[j];
}
DI void store_row_f8(unsigned char* row, const f32x4 (&v)[4], int lane, float sc) {
#pragma unroll
    for (int j = 0; j < 4; ++j) *(unsigned*)(row + 4 * lane + 256 * j) = pk4f8(v[j][0] * sc, v[j][1] * sc, v[j][2] * sc, v[j][3] * sc);
}
DI void store_row_bf16(bf16_t* row, const f32x4 (&v)[4], int lane) {
#pragma unroll
    for (int j = 0; j < 4; ++j) { u32x2 w; w.x = pk2(v[j][0], v[j][1]); w.y = pk2(v[j][2], v[j][3]); *(u32x2*)(row + 4 * lane + 256 * j) = w; }
}

DI void phase_proA(const Frame& F_) {
    const Frame F = refresh(F_);
    const int gw = F.bid * 8 + F.wave, NGW = F.G * 8;
    if (EN(16)) {
        LAS float* scr = (LAS float*)(F.lds + F.wave * 16640);
        constexpr int I_WIN = 4 * 16 * 92, I_WKV = 4 * 16 * 16, I_BR = 4 * 8 * 16, I_WOUT = 4 * 16 * 16, I_W1 = 128 * 16 * 32, I_W2 = 128 * 16 * 16;
        constexpr int I_WG = 4 * 16 * 48; constexpr int NIT = I_WIN + I_WKV + 3 * I_BR + I_WOUT + I_W1 + I_W2 + I_WG;
        for (int it = gw; it < NIT; it += NGW) {
            int r = it;
#ifdef TR_LIM
            if (r >= TR_LIM) break;
#endif
            if (r < I_W1) { const int mat = r >> 9, i = r & 511; tr_item8(inp(F, 25) + (size_t)mat * 1024 * 2048, 1024, 2048, WSP(unsigned char, WS_W1) + (size_t)mat * 2048 * 1024, 64.0f, scr, i, F.lane); continue; } r -= I_W1;
            if (r < I_W2) { const int mat = r >> 8, i = r & 255; tr_item8(inp(F, 27) + (size_t)mat * 1024 * 1024, 1024, 1024, WSP(unsigned char, WS_W2) + (size_t)mat * 1024 * 1024, 128.0f, scr, i, F.lane); continue; } r -= I_W2;
            if (r < I_WIN) { const int mat = r / 1472, i = r % 1472; tr_item(inp(F, 4) + (size_t)mat * 1024 * INC, 1024, INC, WSP(bf16_t, WS_WIN) + (size_t)mat * INC * 1024, scr, i, F.lane); continue; } r -= I_WIN;
            if (r < I_WKV) { const int mat = r >> 8, i = r & 255; tr_item(inp(F, 16) + (size_t)mat * 1024 * 1024, 1024, 1024, WSP(bf16_t, WS_WKV) + (size_t)mat * 1024 * 1024, scr, i, F.lane); continue; } r -= I_WKV;
            if (r < I_BR) { const int mat = r >> 7, i = r & 127; tr_item(inp(F, 17) + (size_t)mat * 512 * 1024, 512, 1024, WSP(bf16_t, WS_WBR) + ((size_t)0 * 4 + mat) * 1024 * 512, scr, i, F.lane); continue; } r -= I_BR;
            if (r < I_BR) { const int mat = r >> 7, i = r & 127; tr_item(inp(F, 18) + (size_t)mat * 512 * 1024, 512, 1024, WSP(bf16_t, WS_WBR) + ((size_t)1 * 4 + mat) * 1024 * 512, scr, i, F.lane); continue; } r -= I_BR;
            if (r < I_BR) { const int mat = r >> 7, i = r & 127; tr_item(inp(F, 19) + (size_t)mat * 512 * 1024, 512, 1024, WSP(bf16_t, WS_WBR) + ((size_t)2 * 4 + mat) * 1024 * 512, scr, i, F.lane); continue; } r -= I_BR;
            if (r < I_WOUT) { const int mat = r >> 8, i = r & 255; tr_item(inp(F, 20) + (size_t)mat * 1024 * 1024, 1024, 1024, WSP(bf16_t, WS_WOUT) + (size_t)mat * 1024 * 1024, scr, i, F.lane); continue; } r -= I_WOUT;
            { const int mat = r / 768, i = r % 768; tr_item8g(inp(F, 4) + (size_t)mat * 1024 * INC + 2816, 1024, INC, 3072, WSP(unsigned char, WS_WG8) + (size_t)mat * 3072 * 1024, 64.0f, scr, i, F.lane); }
        }
    }
    if (EN(17)) for (int m = gw; m < NTOK; m += NGW) {
        f32x4 v[4];
#pragma unroll
        for (int j = 0; j < 4; ++j) v[j] = *(const f32x4*)(inp(F, 0) + (size_t)m * DM + 4 * F.lane + 256 * j);
        ln_rowv(v, inp(F, 2), inp(F, 3), F.lane);
        store_row_bf16(WSP(bf16_t, WS_XB) + (size_t)m * DM, v, F.lane); store_row_f8(WSP(unsigned char, WS_X8) + (size_t)m * DM, v, F.lane, 16.0f);
    }
    for (int m = gw; m < 512; m += NGW) {
        f32x4 v[4];
#pragma unroll
        for (int j = 0; j < 4; ++j) v[j] = *(const f32x4*)(inp(F, 1) + (size_t)m * DM + 4 * F.lane + 256 * j);
        store_row_bf16(WSP(bf16_t, WS_MEMB) + (size_t)m * DM, v, F.lane);
    }
    { const int gt = F.bid * 512 + F.tid, NT = F.G * 512;
      for (int i = gt; i < 4 * 32 * 1024; i += NT) { const int l = i >> 15, e = (i >> 10) & 31, k = i & 1023; const float w = inp(F, 23)[((size_t)l * 1024 + k) * 32 + e];
          const unsigned hi = pk2(w, 0.f) & 0xffffu; const unsigned lo = pk2(w - bflo(hi), 0.f) & 0xffffu; bf16_t* d = WSP(bf16_t, WS_RW) + (size_t)l * 2 * 32 * 1024 + (size_t)e * 1024 + k; d[0] = (bf16_t)hi; d[32 * 1024] = (bf16_t)lo; }
      for (int i = gt; i < PMAX; i += NT) WSP(int, WS_ROUTE + RT_IOTA)[i] = i;
      { const float inv[8] = {1.0f, 1.939227432e-01f, 3.760603070e-02f, 7.292664610e-03f, 1.414213562e-03f, 2.742481884e-04f, 5.318295734e-05f, 1.031338525e-05f};
        for (int i = gt; i < SEQ; i += NT) {
#pragma unroll
            for (int j = 0; j < 8; ++j) { const double rev = (double)((float)i * inv[j]) * 0.15915494309189535; const float fr2 = (float)(2.0 * (rev - floor(rev))); float sn, cs; sincospif(fr2, &sn, &cs);
                WSP(f32x2, WS_ROPE)[i * 8 + j] = (f32x2){cs, sn}; } } }
      for (int i = gt; i < 4 * 2048 * 64; i += NT) { const int l = i >> 17, n = (i >> 6) & 2047, k = i & 63; const float w = inp(F, 12)[((size_t)l * 64 + k) * 2048 + n];
          const unsigned hi = pk2(w, 0.f) & 0xffffu; const unsigned lo = pk2(w - bflo(hi), 0.f) & 0xffffu; bf16_t* d = WSP(bf16_t, WS_FW) + ((size_t)l * 2048 + n) * 256;
          d[k] = (bf16_t)hi; d[64 + k] = (bf16_t)hi; d[128 + k] = (bf16_t)lo; d[192 + k] = 0; }
    }
    __syncthreads();
    if (EN(18)) {
        LAS float* zs = (LAS float*)F.lds;
        LAS float* ha = zs + 64 * 33;
        LAS float* hb = ha + 64 * 65;
        for (int u = F.bid; u < 4 * 256; u += F.G) {
            const int l = u >> 8, t0 = (u & 255) * 64;
            for (int idx = F.tid; idx < 64 * 33; idx += 512) { const int tt = idx / 33, f = idx - tt * 33, t = t0 + tt; float val;
                if (f == 0) val = (float)t * (1.0f / (float)(SEQ - 1));
                else { const int bi = (f - 1) & 15; const double band = 1e-4 + (double)bi * ((15.0 - 1e-4) / 15.0); const double rev = band * (double)t * (1.0 / (double)SEQ); const float fr2 = (float)(2.0 * (rev - floor(rev)));
                    float s, c; sincospif(fr2, &s, &c); val = (f <= 16) ? c : -s; }
                zs[idx] = val; }
            __syncthreads();
            const int tt = F.tid >> 3, j0 = (F.tid & 7) * 8;
            const float* f1w = inp(F, 8) + (size_t)l * 33 * 64; const float* f1b = inp(F, 9) + l * 64; const float* frq = inp(F, 13) + l * 64;
            { float a[8];
#pragma unroll
              for (int j = 0; j < 8; ++j) a[j] = f1b[j0 + j];
              for (int f = 0; f < 33; ++f) { const float z = zs[tt * 33 + f];
#pragma unroll
                  for (int j = 0; j < 8; ++j) a[j] += z * f1w[f * 64 + j0 + j]; }
#pragma unroll
              for (int j = 0; j < 8; ++j) ha[tt * 65 + j0 + j] = __sinf(frq[j0 + j] * a[j]); }
            __syncthreads();
#pragma unroll 1
            for (int i = 0; i < 2; ++i) {
                const float* f2w = inp(F, 10) + ((size_t)l * 2 + i) * 64 * 64; const float* f2b = inp(F, 11) + (l * 2 + i) * 64;
                LAS float* src = i ? hb : ha; LAS float* dst = i ? ha : hb;
                float a[8];
#pragma unroll
                for (int j = 0; j < 8; ++j) a[j] = f2b[j0 + j];
                for (int f = 0; f < 64; ++f) { const float z = src[tt * 65 + f];
#pragma unroll
                    for (int j = 0; j < 8; ++j) a[j] += z * f2w[f * 64 + j0 + j]; }
#pragma unroll
                for (int j = 0; j < 8; ++j) dst[tt * 65 + j0 + j] = __sinf(frq[j0 + j] * a[j]);
                __syncthreads();
            }
            { bf16_t* d = WSP(bf16_t, WS_FH) + ((size_t)l * SEQ + t0 + tt) * 256;
#pragma unroll
              for (int j = 0; j < 8; ++j) { const float h = ha[tt * 65 + j0 + j]; const unsigned hi = pk2(h, 0.f) & 0xffffu; const unsigned lo = pk2(h - bflo(hi), 0.f) & 0xffffu;
                  d[j0 + j] = (bf16_t)hi; d[64 + j0 + j] = (bf16_t)lo; d[128 + j0 + j] = (bf16_t)hi; d[192 + j0 + j] = 0; } }
            __syncthreads();
        }
    }
}

DI constexpr int br5(int x) { return ((x & 1) << 4) | ((x & 2) << 2) | (x & 4) | ((x & 8) >> 2) | ((x & 16) >> 4); }
DI float c32(int k) { switch (k & 15) { case 0: return 1.f; case 1: return 0.980785280f; case 2: return 0.923879533f; case 3: return 0.831469612f; case 4: return 0.707106781f; case 5: return 0.555570233f; case 6: return 0.382683432f; case 7: return 0.195090322f;
    case 8: return 0.f; case 9: return -0.195090322f; case 10: return -0.382683432f; case 11: return -0.555570233f; case 12: return -0.707106781f; case 13: return -0.831469612f; case 14: return -0.923879533f; default: return -0.980785280f; } }
DI float s32(int k) { switch (k & 15) { case 0: return 0.f; case 1: return 0.195090322f; case 2: return 0.382683432f; case 3: return 0.555570233f; case 4: return 0.707106781f; case 5: return 0.831469612f; case 6: return 0.923879533f; case 7: return 0.980785280f;
    case 8: return 1.f; case 9: return 0.980785280f; case 10: return 0.923879533f; case 11: return 0.831469612f; case 12: return 0.707106781f; case 13: return 0.555570233f; case 14: return 0.382683432f; default: return 0.195090322f; } }
DI float c64(int k) { return (k & 1) ? ((k < 16) ? ((k == 1) ? 0.995184727f : (k == 3) ? 0.956940336f : (k == 5) ? 0.881921264f : (k == 7) ? 0.773010453f : (k == 9) ? 0.634393284f : (k == 11) ? 0.471396737f : (k == 13) ? 0.290284677f : 0.098017140f)
                                                 : ((k == 17) ? -0.098017140f : (k == 19) ? -0.290284677f : (k == 21) ? -0.471396737f : (k == 23) ? -0.634393284f : (k == 25) ? -0.773010453f : (k == 27) ? -0.881921264f : (k == 29) ? -0.956940336f : -0.995184727f))
                               : ((k < 16) ? c32(k >> 1) : c32(k >> 1)); }
DI float s64(int k) { return (k & 1) ? ((k < 16) ? ((k == 1) ? 0.098017140f : (k == 3) ? 0.290284677f : (k == 5) ? 0.471396737f : (k == 7) ? 0.634393284f : (k == 9) ? 0.773010453f : (k == 11) ? 0.881921264f : (k == 13) ? 0.956940336f : 0.995184727f)
                                                 : ((k == 17) ? 0.995184727f : (k == 19) ? 0.956940336f : (k == 21) ? 0.881921264f : (k == 23) ? 0.773010453f : (k == 25) ? 0.634393284f : (k == 27) ? 0.471396737f : (k == 29) ? 0.290284677f : 0.098017140f))
                               : s32(k >> 1); }
template <int N, int SPAN> DI void dif_stage(float (&re)[N], float (&im)[N]) {
#pragma unroll
    for (int i = 0; i < N; ++i) {
        if ((i & SPAN) == 0) {
            const int j = i + SPAN, tw = (i & (SPAN - 1)) * (N / (2 * SPAN)) * (32 / N);
            const float ar = re[i], ai = im[i], br_ = re[j], bi = im[j];
            re[i] = ar + br_; im[i] = ai + bi;
            const float dr = ar - br_, di = ai - bi;
            if (tw == 0) { re[j] = dr; im[j] = di; }
            else if (tw == 8) { re[j] = di; im[j] = -dr; }
            else { const float c = c32(tw), s = s32(tw); re[j] = dr * c + di * s; im[j] = di * c - dr * s; }
        }
    }
    if constexpr (SPAN > 1) dif_stage<N, SPAN / 2>(re, im);
}
template <int N> DI void dif(float (&re)[N], float (&im)[N]) { dif_stage<N, N / 2>(re, im); }
template <int N, int SPAN> DI void dit_stage(float (&re)[N], float (&im)[N]) {
#pragma unroll
    for (int i = 0; i < N; ++i) {
        if ((i & SPAN) == 0) {
            const int j = i + SPAN, tw = (i & (SPAN - 1)) * (N / (2 * SPAN)) * (32 / N);
            const float br_ = re[j], bi = im[j]; float tr, ti;
            if (tw == 0) { tr = br_; ti = bi; }
            else if (tw == 8) { tr = bi; ti = -br_; }
            else { const float c = c32(tw), s = s32(tw); tr = br_ * c + bi * s; ti = bi * c - br_ * s; }
            const float ar = re[i], ai = im[i];
            re[j] = ar - tr; im[j] = ai - ti; re[i] = ar + tr; im[i] = ai + ti;
        }
    }
    if constexpr (SPAN * 2 < N) dit_stage<N, SPAN * 2>(re, im);
}
template <int N> DI void dit(float (&re)[N], float (&im)[N]) { dit_stage<N, 1>(re, im); }
DI void tw_powers(float w1r, float w1i, float (&wr)[32], float (&wi)[32]) {
    wr[0] = 1.f; wi[0] = 0.f; wr[1] = w1r; wi[1] = w1i;
#pragma unroll
    for (int k = 2; k < 32; ++k) {
        if ((k & 1) == 0) { const float a = wr[k >> 1], b = wi[k >> 1]; wr[k] = a * a - b * b; wi[k] = 2.f * a * b; }
        else { const float a = wr[k - 1], b = wi[k - 1]; wr[k] = a * w1r - b * w1i; wi[k] = a * w1i + b * w1r; }
    }
}
#define OPQ(x) asm volatile("" : "+v"(x))
constexpr int FB = 528;
#define TW_STEP(wr, wi, w1r, w1i) do { const float t_ = wr * w1r - wi * w1i; wi = wr * w1i + wi * w1r; wr = t_; } while (0)
DI void fft_fwd(float (&zr)[32], float (&zi)[32], LAS f32x2* lds, int tid_) {
    dif<32>(zr, zi);
    int tid = tid_; OPQ(tid);
    { float s1, c1; s1 = __builtin_amdgcn_sinf(0.5f * ((float)tid * (1.0f / 8192.0f))); c1 = __builtin_amdgcn_cosf(0.5f * ((float)tid * (1.0f / 8192.0f))); const float w1r = c1, w1i = -s1; float wr = 1.f, wi = 0.f;
#pragma unroll
      for (int k = 0; k < 32; ++k) { const float a = zr[br5(k)], b = zi[br5(k)]; lds[k * FB + tid] = (f32x2){a * wr - b * wi, a * wi + b * wr}; TW_STEP(wr, wi, w1r, w1i); if ((k & 3) == 3) __builtin_amdgcn_sched_barrier(0); } }
    __syncthreads();
    tid = tid_; OPQ(tid);
    const int blk = tid >> 4, n2 = tid & 15;
#pragma unroll
    for (int j = 0; j < 32; ++j) { const f32x2 v = lds[blk * FB + 16 * j + n2]; zr[j] = v.x; zi[j] = v.y; }
    __syncthreads();
    dif<32>(zr, zi);
    { float s1, c1; s1 = __builtin_amdgcn_sinf(0.5f * ((float)n2 * (1.0f / 256.0f))); c1 = __builtin_amdgcn_cosf(0.5f * ((float)n2 * (1.0f / 256.0f))); const float w1r = c1, w1i = -s1; float wr = 1.f, wi = 0.f;
#pragma unroll
      for (int k = 0; k < 32; ++k) { const float a = zr[br5(k)], b = zi[br5(k)]; lds[blk * FB + n2 * 33 + k] = (f32x2){a * wr - b * wi, a * wi + b * wr}; TW_STEP(wr, wi, w1r, w1i); if ((k & 3) == 3) __builtin_amdgcn_sched_barrier(0); } }
    __syncthreads();
#pragma unroll
    for (int r = 0; r < 2; ++r) { float cr[16], ci[16];
#pragma unroll
        for (int n = 0; n < 16; ++n) { const f32x2 v = lds[blk * FB + n * 33 + n2 + 16 * r]; cr[n] = v.x; ci[n] = v.y; }
        dif<16>(cr, ci);
#pragma unroll
        for (int q = 0; q < 16; ++q) { zr[r * 16 + q] = cr[q]; zi[r * 16 + q] = ci[q]; } }
    __syncthreads();
}
DI void fft_inv(float (&zr)[32], float (&zi)[32], LAS f32x2* lds, int tid_) {
    int tid = tid_; OPQ(tid);
    const int blk = tid >> 4, n2 = tid & 15;
#pragma unroll
    for (int r = 0; r < 2; ++r) { float cr[16], ci[16];
#pragma unroll
        for (int q = 0; q < 16; ++q) { cr[q] = zr[r * 16 + q]; ci[q] = -zi[r * 16 + q]; }
        dit<16>(cr, ci);
#pragma unroll
        for (int n = 0; n < 16; ++n) lds[blk * FB + n * 33 + n2 + 16 * r] = (f32x2){cr[n], ci[n]}; }
    __syncthreads();
    { float wr[32], wi[32]; float s1, c1; s1 = __builtin_amdgcn_sinf(0.5f * ((float)n2 * (1.0f / 256.0f))); c1 = __builtin_amdgcn_cosf(0.5f * ((float)n2 * (1.0f / 256.0f))); tw_powers(c1, -s1, wr, wi);
#pragma unroll
      for (int k = 0; k < 32; ++k) { const f32x2 v = lds[blk * FB + n2 * 33 + k]; zr[k] = v.x * wr[k] - v.y * wi[k]; zi[k] = v.x * wi[k] + v.y * wr[k]; } }
    __syncthreads();
    dif<32>(zr, zi);
#pragma unroll
    for (int j = 0; j < 32; ++j) lds[blk * FB + 16 * j + n2] = (f32x2){zr[br5(j)], zi[br5(j)]};
    __syncthreads();
    { int tid2 = tid_; OPQ(tid2); float wr[32], wi[32]; float s1, c1; s1 = __builtin_amdgcn_sinf(0.5f * ((float)tid2 * (1.0f / 8192.0f))); c1 = __builtin_amdgcn_cosf(0.5f * ((float)tid2 * (1.0f / 8192.0f))); tw_powers(c1, -s1, wr, wi);
#pragma unroll
      for (int k = 0; k < 32; ++k) { const f32x2 v = lds[k * FB + tid2]; zr[k] = v.x * wr[k] - v.y * wi[k]; zi[k] = v.x * wi[k] + v.y * wr[k]; } }
    __syncthreads();
    dif<32>(zr, zi);
    float tr[32], ti[32];
#pragma unroll
    for (int j = 0; j < 32; ++j) { tr[j] = zr[br5(j)] * (1.0f / (float)SEQ); ti[j] = -zi[br5(j)] * (1.0f / (float)SEQ); }
#pragma unroll
    for (int j = 0; j < 32; ++j) { zr[j] = tr[j]; zi[j] = ti[j]; }
}
DI void hyena_unit(const Frame& F_, int l, int c) {
    const Frame F = refresh(F_);
    LAS f32x2* lds = (LAS f32x2*)F.lds; const int tid0 = F.tid; constexpr int L = SEQ;
#define TWIST(j, wr, wi) const float wr = twr_ * c64(j) + twi_ * s64(j), wi = twi_ * c64(j) - twr_ * s64(j)
    bf16_t* y2 = WSP(bf16_t, WS_Y2) + (size_t)c * NTOK;
    unsigned* SP = WSP(unsigned, WS_FFTS) + (size_t)F.bid * 131072; unsigned* ZS = SP + 65536; unsigned* YE = SP + 81920; unsigned* GX = SP + 98304;
    { const bf16_t* ZT = WSP(bf16_t, WS_ZT); const float* cw = inp(F, 6) + (size_t)l * 3 * 1536; const float* cb = inp(F, 7) + l * 1536;
#pragma unroll 1
      for (int part = 0; part < 3; ++part) { const int ch = part * 512 + c; const bf16_t* z0 = ZT + (size_t)ch * NTOK; const float w0 = cw[ch], w1 = cw[1536 + ch], w2 = cw[3072 + ch], bb = cb[ch];
          unsigned* dst = part == 0 ? ZS : GX + (size_t)(part - 1) * 16384;
#pragma unroll 4
          for (int ck = tid0; ck < 2048; ck += 512) { const unsigned t0 = 8u * (unsigned)ck;
              float za[10], zb[10];
              { const u32x4 v = *(const u32x4*)(z0 + t0), w = *(const u32x4*)(z0 + L + t0);
#pragma unroll
                for (int q = 0; q < 4; ++q) { za[1 + 2 * q] = bflo(v[q]); za[2 + 2 * q] = bfhi(v[q]); zb[1 + 2 * q] = bflo(w[q]); zb[2 + 2 * q] = bfhi(w[q]); } }
              const unsigned tm = (t0 > 0u) ? t0 - 1u : 0u, tp = (t0 + 8u < (unsigned)L) ? t0 + 8u : t0;
              za[0] = bflo((unsigned)z0[tm]); zb[0] = bflo((unsigned)z0[L + tm]); za[9] = bflo((unsigned)z0[tp]); zb[9] = bflo((unsigned)z0[L + tp]);
              if (t0 == 0u) { za[0] = 0.f; zb[0] = 0.f; } if (t0 + 8u == (unsigned)L) { za[9] = 0.f; zb[9] = 0.f; }
              u32x4 o0, o1;
#pragma unroll
              for (int q = 0; q < 8; ++q) { const unsigned w = pkh(w0 * za[q] + w1 * za[q + 1] + w2 * za[q + 2] + bb, w0 * zb[q] + w1 * zb[q + 1] + w2 * zb[q + 2] + bb); if (q < 4) o0[q] = w; else o1[q - 4] = w; }
              *(u32x4*)(dst + t0) = o0; *(u32x4*)(dst + t0 + 4) = o1; } } }
    float twr, twi; { float s, cc; s = __builtin_amdgcn_sinf(0.5f * ((float)tid0 * (1.0f / 16384.0f))); cc = __builtin_amdgcn_cosf(0.5f * ((float)tid0 * (1.0f / 16384.0f))); twr = cc; twi = -s; }
#define TWIST_NEXT(wr, wi) do { const float t_ = wr * 0.995184727f + wi * 0.098017140f; wi = wi * 0.995184727f - wr * 0.098017140f; wr = t_; } while (0)
    { const _Float16* hf0 = WSP(_Float16, WS_HF) + ((size_t)l * 2048 + c) * L;
      const float skip0 = inp(F, 14)[(l * 2 + 0) * 512 + c], skip1 = inp(F, 14)[(l * 2 + 1) * 512 + c];
      const float dl = (3.070113457325394f + (float)c * ((15.350567286626971f - 3.070113457325394f) / 511.0f)) * (1.4426950408889634f / (float)(SEQ - 1));
#pragma unroll 1
      for (int par = 0; par < 2; ++par) {
        float ar[32], ai[32];
        { unsigned tid = tid0; OPQ(tid); float twr_ = twr, twi_ = twi; OPQ(twr_); OPQ(twi_);
#pragma unroll
          for (int j = 0; j < 32; ++j) { const unsigned m = 512u * j + tid; const unsigned mb = (m > 0u) ? (unsigned)L - m : 1u;
              const float wf = __builtin_amdgcn_exp2f(-(float)m * dl - 8.0f), wb = (m > 0u) ? __builtin_amdgcn_exp2f(-(float)mb * dl - 8.0f) : 0.f;
              float f0 = (float)hf0[m] * wf, f1 = (float)hf0[(size_t)1024 * L + m] * wf; const float b0 = (float)hf0[(size_t)512 * L + mb] * wb, b1 = (float)hf0[(size_t)1536 * L + mb] * wb;
              if (j == 0) { f0 += (tid == 0u) ? skip0 : 0.f; f1 += (tid == 0u) ? skip1 : 0.f; }
              if (par == 0) { ar[j] = f0 + b0; ai[j] = f1 + b1; }
              else { const float d0 = f0 - b0, d1 = f1 - b1; ar[j] = d0 * twr_ - d1 * twi_; ai[j] = d0 * twi_ + d1 * twr_; TWIST_NEXT(twr_, twi_); }
              if ((j & 3) == 3) __builtin_amdgcn_sched_barrier(0); } }
        fft_fwd(ar, ai, lds, tid0);
        { unsigned tid = tid0; OPQ(tid);
#pragma unroll
          for (int i = 0; i < 32; ++i) lds[i * 512u + tid] = (f32x2){ar[i], ai[i]};
          __syncthreads();
          unsigned* S0 = SP + (size_t)par * 16384; unsigned* S1 = SP + 32768 + (size_t)par * 16384;
#pragma unroll
          for (int i = 0; i < 32; ++i) {
              unsigned pidx;
              if (par == 1) pidx = (unsigned)(31 - i) * 512u + (511u - tid);
              else if (tid >= 16u) pidx = (unsigned)(31 - i) * 512u + ((32u - (tid >> 4)) * 16u + 15u - (tid & 15u));
              else { const unsigned k1p = (tid & 15u) + 16u * (unsigned)(i >> 4); const unsigned qq = (unsigned)(i & 15);
                     if (k1p != 0u) { const unsigned nk = 32u - k1p; pidx = ((nk >> 4) * 16u + 15u - qq) * 512u + (nk & 15u); }
                     else { const unsigned k2 = ((qq & 1u) << 3) | ((qq & 2u) << 1) | ((qq & 4u) >> 1) | ((qq & 8u) >> 3); const unsigned nk2 = (16u - k2) & 15u;
                            const unsigned nq = ((nk2 & 1u) << 3) | ((nk2 & 2u) << 1) | ((nk2 & 4u) >> 1) | ((nk2 & 8u) >> 3); pidx = nq * 512u; } }
              const f32x2 p = lds[pidx];
              const float sr = 0.5f * (ar[i] + p.x), si = 0.5f * (ai[i] - p.y), dr = 0.5f * (ar[i] - p.x), di = 0.5f * (ai[i] + p.y);
              S0[i * 512u + tid] = pkh(sr, si); S1[i * 512u + tid] = pkh(di, -dr); }
          __syncthreads(); }
      } }
#pragma unroll 1
    for (int o = 0; o < 2; ++o) {
        const unsigned* gx = GX + (size_t)o * 16384;
        float ar[32], ai[32];
        const unsigned* SPE = SP + (size_t)o * 32768; const unsigned* SPO = SPE + 16384;
        { unsigned tid = tid0; OPQ(tid);
#pragma unroll
          for (int j = 0; j < 32; ++j) { const f32x2 v = unh(ZS[j * 512u + tid]); ar[j] = v.x; ai[j] = v.y; } }
        fft_fwd(ar, ai, lds, tid0);
        { unsigned tid = tid0; OPQ(tid);
#pragma unroll
          for (int i = 0; i < 32; ++i) { const f32x2 k = unh(SPE[i * 512u + tid]); const float a = ar[i], b = ai[i]; ar[i] = a * k.x - b * k.y; ai[i] = a * k.y + b * k.x; } }
        fft_inv(ar, ai, lds, tid0);
        { unsigned tid = tid0; OPQ(tid);
#pragma unroll
          for (int j = 0; j < 32; ++j) YE[j * 512u + tid] = pkh(ar[j], ai[j]); }
        { unsigned tid = tid0; OPQ(tid); float twr_ = twr, twi_ = twi; OPQ(twr_); OPQ(twi_);
#pragma unroll
          for (int j = 0; j < 32; ++j) { const f32x2 v = unh(ZS[j * 512u + tid]); ar[j] = v.x; ai[j] = v.y; }
#pragma unroll
          for (int j = 0; j < 32; ++j) { TWIST(j, wr, wi); const float a = ar[j], b = ai[j]; ar[j] = a * wr - b * wi; ai[j] = a * wi + b * wr; } }
        fft_fwd(ar, ai, lds, tid0);
        { unsigned tid = tid0; OPQ(tid);
#pragma unroll
          for (int i = 0; i < 32; ++i) { const f32x2 k = unh(SPO[i * 512u + tid]); const float a = ar[i], b = ai[i]; ar[i] = a * k.x - b * k.y; ai[i] = a * k.y + b * k.x; } }
        fft_inv(ar, ai, lds, tid0);
        { unsigned tid = tid0; OPQ(tid); float twr_ = twr, twi_ = twi; OPQ(twr_); OPQ(twi_);
#pragma unroll
          for (int j = 0; j < 32; ++j) { const unsigned n = 512u * j + tid;
            TWIST(j, wr, wi);
            const float yor = ar[j] * wr + ai[j] * wi, yoi = ai[j] * wr - ar[j] * wi;
            const f32x2 ye = unh(YE[j * 512u + tid]);
            const f32x2 gg = unh(gx[j * 512u + tid]);
            const float o0 = gg.x * 0.5f * (ye.x + yor), o1 = gg.y * 0.5f * (ye.y + yoi);
            if (o == 0) ZS[j * 512u + tid] = pkh(o0, o1); else { y2[n] = (bf16_t)(pk2(o0, 0.f) & 0xffffu); y2[(unsigned)L + n] = (bf16_t)(pk2(o1, 0.f) & 0xffffu); }
            if ((j & 3) == 3) __builtin_amdgcn_sched_barrier(0); } }
        __syncthreads();
    }
#undef TWIST
}

DI int crow(int reg, int h) { return (reg & 3) + 8 * (reg >> 2) + 4 * h; }
template <int NKT, int NST, int NDT, bool SWA>
DI void attn_sub(const LAS unsigned char* Ks, int kstride, const LAS unsigned char* Vt, int vstride, int key0,
                 const bf16_t* qptr, bf16_t* optr, float scale, float sink, int kpos0, int lane, const f32x4* rt = nullptr) {
    const int r = lane & 31, h = lane >> 5;
    int rq = r; OPQ(rq);
    bf16x8 q[NST];
#pragma unroll
    for (int s = 0; s < NST; ++s) q[s] = *(const bf16x8*)(qptr + 16 * s + 8 * h);
    if (SWA) {
        u32x4 mine = __builtin_bit_cast(u32x4, q[0]), oth, res;
#pragma unroll
        for (int j = 0; j < 4; ++j) oth[j] = (unsigned)__shfl_xor((int)mine[j], 32);
#pragma unroll
        for (int j = 0; j < 4; ++j) { const f32x4 cs = rt[j]; const float m0 = bflo(mine[j]), m1 = bfhi(mine[j]), o0 = bflo(oth[j]), o1 = bfhi(oth[j]);
            res[j] = h ? pk2(m0 * cs[0] + o0 * cs[1], m1 * cs[2] + o1 * cs[3]) : pk2(m0 * cs[0] - o0 * cs[1], m1 * cs[2] - o1 * cs[3]); }
        q[0] = __builtin_bit_cast(bf16x8, res);
    }
    f32x16 O[NDT];
#pragma unroll
    for (int dt = 0; dt < NDT; ++dt)
#pragma unroll
        for (int x = 0; x < 16; ++x) O[dt][x] = 0.f;
    const float sink2 = sink * 1.4426950408889634f;
    float m = SWA ? sink2 : -3.0e38f, lsum = 0.f;
#pragma unroll
    for (int i = 0; i < NKT; ++i) {
        f32x16 a16;
#pragma unroll
        for (int x = 0; x < 16; ++x) a16[x] = 0.f;
#pragma unroll
        for (int s = 0; s < NST; ++s) { const bf16x8 a = *(const LAS bf16x8*)(Ks + (key0 + 32 * i + r) * kstride + (16 * s + 8 * h) * 2); a16 = __builtin_amdgcn_mfma_f32_32x32x16_bf16(a, q[s], a16, 0, 0, 0); }
        float tmax = -3.0e38f;
#pragma unroll
        for (int x = 0; x < 16; ++x) { float v = a16[x] * (scale * 1.4426950408889634f);
            if (SWA) { const int kk = 32 * i + crow(x, h); const int d = kk - 128 - rq; bool valid = (unsigned)(kpos0 + kk) < (unsigned)SEQ;
                if (i == 0) valid = valid && (d >= -128); if (i == NKT - 1) valid = valid && (d <= 128); v = valid ? v : -1e30f; }
            a16[x] = v; tmax = fmaxf(tmax, v); }
        tmax = fmaxf(tmax, __shfl_xor(tmax, 32));
        const float mn = fmaxf(m, tmax), corr = __builtin_amdgcn_exp2f(m - mn); m = mn;
        float ps = 0.f;
#pragma unroll
        for (int x = 0; x < 16; ++x) { const float p = __builtin_amdgcn_exp2f(a16[x] - mn); a16[x] = p; ps += p; }
        lsum = lsum * corr + ps;
        bf16x8 P[2];
#pragma unroll
        for (int s2 = 0; s2 < 2; ++s2) { u32x4 w;
#pragma unroll
            for (int j = 0; j < 4; ++j) w[j] = pk2(a16[8 * s2 + 2 * j], a16[8 * s2 + 2 * j + 1]);
            P[s2] = __builtin_bit_cast(bf16x8, w); }
#pragma unroll
        for (int dt = 0; dt < NDT; ++dt) {
#pragma unroll
            for (int x = 0; x < 16; ++x) O[dt][x] *= corr;
#pragma unroll
            for (int s2 = 0; s2 < 2; ++s2) { const LAS unsigned char* vp = Vt + (32 * dt + r) * vstride + (key0 + 32 * i + 16 * s2 + 4 * h) * 2;
                const s16x4 lo = *(const LAS s16x4*)vp, hi = *(const LAS s16x4*)(vp + 16);
                const bf16x8 a = __builtin_shufflevector(lo, hi, 0, 1, 2, 3, 4, 5, 6, 7);
                O[dt] = __builtin_amdgcn_mfma_f32_32x32x16_bf16(a, P[s2], O[dt], 0, 0, 0); } }
        __builtin_amdgcn_sched_barrier(0);
    }
    lsum += __shfl_xor(lsum, 32);
    if (SWA) lsum += __builtin_amdgcn_exp2f(sink2 - m);
    const float inv = 1.0f / lsum;
#pragma unroll
    for (int dt = 0; dt < NDT; ++dt)
#pragma unroll
        for (int g4 = 0; g4 < 4; ++g4) { u32x2 w; w.x = pk2(O[dt][4 * g4] * inv, O[dt][4 * g4 + 1] * inv); w.y = pk2(O[dt][4 * g4 + 2] * inv, O[dt][4 * g4 + 3] * inv); *(u32x2*)(optr + 32 * dt + 8 * g4 + 4 * h) = w; }
}
constexpr int SW_KS = 144, SW_VS = 776, SW_VOFF = 384 * SW_KS;
constexpr int MA_KS = 272, MA_VS = 520, MA_VOFF = 256 * MA_KS;
DI void swa_unit(const Frame& F_, int l, int u) {
    const Frame F = refresh(F_);
    const int kvh = u & 1, qblk = (u >> 1) & 127, b = u >> 8;
    const bf16_t* PROJ = WSP(bf16_t, WS_PROJ);
    const int kt0 = (qblk - 1) * 128;
    LAS unsigned char* Ks = F.lds; LAS unsigned char* Vt = F.lds + SW_VOFF; const f32x4* RT = WSP(f32x4, WS_ROPE);
#pragma unroll 2
    for (int it = 0; it < 6; ++it) { const int ch = F.tid + it * 512, key = ch >> 3, qq = ch & 7, tpos = kt0 + key; const bool valid = (tpos >= 0) && (tpos < SEQ);
        const bf16_t* src = PROJ + (size_t)(b * SEQ + (valid ? tpos : 0)) * PJ + kvh * 64 + 8 * qq;
        u32x4 kv = {0u, 0u, 0u, 0u}, vv = {0u, 0u, 0u, 0u}; if (valid) { kv = *(const u32x4*)(src + C_K); vv = *(const u32x4*)(src + C_V); }
        { u32x4 oth;
#pragma unroll
          for (int j = 0; j < 4; ++j) oth[j] = (unsigned)__shfl_xor((int)kv[j], 1);
          if (qq < 2 && valid) { const f32x4* rt = RT + (size_t)tpos * 4;
#pragma unroll
              for (int j = 0; j < 4; ++j) { const f32x4 cs = rt[j]; const float m0 = bflo(kv[j]), m1 = bfhi(kv[j]), o0 = bflo(oth[j]), o1 = bfhi(oth[j]);
                  kv[j] = qq ? pk2(m0 * cs[0] + o0 * cs[1], m1 * cs[2] + o1 * cs[3]) : pk2(m0 * cs[0] - o0 * cs[1], m1 * cs[2] - o1 * cs[3]); } } }
        *(LAS u32x4*)(Ks + key * SW_KS + 16 * qq) = kv;
#pragma unroll
        for (int j = 0; j < 4; ++j) { *(LAS unsigned short*)(Vt + (8 * qq + 2 * j) * SW_VS + key * 2) = (unsigned short)(vv[j] & 0xffffu); *(LAS unsigned short*)(Vt + (8 * qq + 2 * j + 1) * SW_VS + key * 2) = (unsigned short)(vv[j] >> 16); } }
    __syncthreads();
#pragma unroll 1
    for (int i2 = 0; i2 < 2; ++i2) { const int sb = F.wave * 2 + i2, g = sb >> 2, q32 = sb & 3, head = kvh * 4 + g;
        const int qtok = b * SEQ + qblk * 128 + q32 * 32 + (F.lane & 31);
        attn_sub<9, 4, 2, true>(Ks, SW_KS, Vt, SW_VS, q32 * 32, PROJ + (size_t)qtok * PJ + C_Q + head * 64, WSP(bf16_t, WS_YSW) + (size_t)qtok * 512 + head * 64,
                                0.125f, inp(F, 15)[l * 8 + head], kt0 + q32 * 32, F.lane, RT + (size_t)(qblk * 128 + q32 * 32 + (F.lane & 31)) * 4); }
    __syncthreads();
}
DI void mema_unit(const Frame& F_, int l, int u) {
    const Frame F = refresh(F_);
    const int head = u & 3, qc = (u >> 2) & 31, b = u >> 7;
    const bf16_t* PROJ = WSP(bf16_t, WS_PROJ); const bf16_t* MK = WSP(bf16_t, WS_MK) + (size_t)l * 512 * 512; const bf16_t* MVT = WSP(bf16_t, WS_MVT) + (size_t)l * 512 * 512;
    LAS unsigned char* Ks = F.lds; LAS unsigned char* Vt = F.lds + MA_VOFF;
#pragma unroll 2
    for (int it = 0; it < 8; ++it) { const int ch = F.tid + it * 512; { const int key = ch >> 4, qq = ch & 15; *(LAS u32x4*)(Ks + key * MA_KS + 16 * qq) = *(const u32x4*)(MK + (size_t)(b * 256 + key) * 512 + head * 128 + 8 * qq); }
        { const int d = ch >> 5, qq = ch & 31; const u32x4 v = *(const u32x4*)(MVT + (size_t)(head * 128 + d) * 512 + b * 256 + 8 * qq); LAS u32x2* dst = (LAS u32x2*)(Vt + d * MA_VS + 16 * qq); dst[0] = (u32x2){v.x, v.y}; dst[1] = (u32x2){v.z, v.w}; } }
    __syncthreads();
#pragma unroll 1
    for (int i2 = 0; i2 < 2; ++i2) { const int qtok = b * SEQ + qc * 512 + F.wave * 64 + i2 * 32 + (F.lane & 31);
        attn_sub<8, 8, 4, false>(Ks, MA_KS, Vt, MA_VS, 0, PROJ + (size_t)qtok * PJ + C_MQ + head * 128, WSP(bf16_t, WS_YMEM) + (size_t)qtok * 512 + head * 128, 0.08838834764831845f, 0.f, 0, F.lane); }
    __syncthreads();
}

DI void phase_conv_rope(const Frame& F_, int l) {
    const Frame F = refresh(F_);
    const int gt = F.bid * 512 + F.tid, NT = F.G * 512;
    { const bf16_t* ZT = WSP(bf16_t, WS_ZT); float* ZC = WSP(float, WS_ZC); const float* cw = inp(F, 6) + (size_t)l * 3 * 1536; const float* cb = inp(F, 7) + l * 1536;
      for (int idx = gt; idx < 1536 * 4096; idx += NT) { const int c = idx >> 12, tok0 = (idx & 4095) * 8; const bf16_t* zr = ZT + (size_t)c * NTOK + tok0;
          const u32x4 v = *(const u32x4*)zr;
          const float prev = ((tok0 & (SEQ - 1)) == 0) ? 0.f : bflo((unsigned)zr[-1]), next = (((tok0 + 8) & (SEQ - 1)) == 0) ? 0.f : bflo((unsigned)zr[8]);
          const float w0 = cw[c], w1 = cw[1536 + c], w2 = cw[3072 + c], bb = cb[c];
          float z[10]; z[0] = prev; z[9] = next;
#pragma unroll
          for (int j = 0; j < 4; ++j) { z[1 + 2 * j] = bflo(v[j]); z[2 + 2 * j] = bfhi(v[j]); }
          f32x4 o0, o1;
#pragma unroll
          for (int j = 0; j < 4; ++j) { o0[j] = w0 * z[j] + w1 * z[j + 1] + w2 * z[j + 2] + bb; o1[j] = w0 * z[j + 4] + w1 * z[j + 5] + w2 * z[j + 6] + bb; }
          float* op = ZC + (size_t)c * NTOK + tok0; *(f32x4*)op = o0; *(f32x4*)(op + 4) = o1; } }
    bf16_t* PROJ = WSP(bf16_t, WS_PROJ); const f32x4* RT = WSP(f32x4, WS_ROPE);
    for (int idx = gt; idx < NTOK * 10; idx += NT) { const int tok = idx / 10, hh = idx - tok * 10, pos = tok & (SEQ - 1);
        bf16_t* p = PROJ + (size_t)tok * PJ + (hh < 8 ? C_Q + hh * 64 : C_K + (hh - 8) * 64);
        const u32x4 x1 = *(const u32x4*)p, x2 = *(const u32x4*)(p + 8); u32x4 y1, y2;
#pragma unroll
        for (int j = 0; j < 4; ++j) { const f32x4 cs = RT[pos * 4 + j];
            const float a0 = bflo(x1[j]), a1 = bfhi(x1[j]), b0 = bflo(x2[j]), b1 = bfhi(x2[j]);
            y1[j] = pk2(a0 * cs[0] - b0 * cs[1], a1 * cs[2] - b1 * cs[3]); y2[j] = pk2(b0 * cs[0] + a0 * cs[1], b1 * cs[2] + a1 * cs[3]); }
        *(u32x4*)p = y1; *(u32x4*)(p + 8) = y2; }
}
DI void phase_tr_y2(const Frame& F_) {
    const Frame F = refresh(F_);
    const int gw = F.bid * 8 + F.wave, NGW = F.G * 8, lane = F.lane;
    LAS float* scr = (LAS float*)(F.lds + F.wave * 16640);
    for (int it = gw; it < 8 * 512; it += NGW) { const int ct = it & 7, tt = it >> 3, c0 = ct * 64, tok0 = tt * 64;
        const bf16_t* src = WSP(bf16_t, WS_Y2) + (size_t)c0 * NTOK + tok0 + lane;
#pragma unroll 8
        for (int ch = 0; ch < 64; ++ch) scr[ch * 65 + lane] = bflo((unsigned)src[(size_t)ch * NTOK]);
        LDS_WAIT();
        const int kc = lane & 7;
#pragma unroll
        for (int i = 0; i < 8; ++i) { const int tk = 8 * i + (lane >> 3); const LAS float* s = scr + (8 * kc) * 65 + tk;
            u32x4 o; o.x = pk2(s[0], s[65]); o.y = pk2(s[2 * 65], s[3 * 65]); o.z = pk2(s[4 * 65], s[5 * 65]); o.w = pk2(s[6 * 65], s[7 * 65]);
            *(u32x4*)(WSP(bf16_t, WS_YHY) + (size_t)(tok0 + tk) * 512 + c0 + 8 * kc) = o; }
        LDS_WAIT(); }
}

DI void phase_ln1_router(const Frame& F_, int l) {
    const Frame F = refresh(F_);
    LAS float* lg = (LAS float*)F.lds + F.wave * 512;
    volatile LAS int* cnt = (volatile LAS int*)(F.MISC + 16);
    const bf16_t* RWB = WSP(bf16_t, WS_RW) + (size_t)l * 2 * 32 * 1024;
    const float* rb = inp(F, 24) + l * 32; const float* g1 = inp(F, 21) + l * DM; const float* b1 = inp(F, 22) + l * DM;
    const int lane = F.lane, rr = lane & 15, g = lane >> 4;
    for (int chunk = F.bid; chunk < NCHUNK; chunk += F.G) {
        if (F.tid < 32) cnt[F.tid] = 0;
        __syncthreads();
        const int row = chunk * CHUNK + F.wave * 16 + rr;
        const bf16_t* xr = WSP(bf16_t, WS_R) + (size_t)row * DM + 8 * g;
        float s1 = 0.f, s2 = 0.f;
#pragma unroll 4
        for (int s = 0; s < 32; ++s) { const u32x4 rw_ = *(const u32x4*)(xr + 32 * s); const f32x4 a = {bflo(rw_.x), bfhi(rw_.x), bflo(rw_.y), bfhi(rw_.y)}, b = {bflo(rw_.z), bfhi(rw_.z), bflo(rw_.w), bfhi(rw_.w)};
            s1 += (a[0] + a[1]) + (a[2] + a[3]) + (b[0] + b[1]) + (b[2] + b[3]);
            s2 += (a[0] * a[0] + a[1] * a[1]) + (a[2] * a[2] + a[3] * a[3]) + (b[0] * b[0] + b[1] * b[1]) + (b[2] * b[2] + b[3] * b[3]); }
        s1 += __shfl_xor(s1, 16); s1 += __shfl_xor(s1, 32); s2 += __shfl_xor(s2, 16); s2 += __shfl_xor(s2, 32);
        const float mean = s1 * (1.f / DM), rstd = 1.f / sqrtf(fmaxf(s2 * (1.f / DM) - mean * mean, 0.f) + LN_EPS);
        f32x4 acc0 = {0.f, 0.f, 0.f, 0.f}, acc1 = {0.f, 0.f, 0.f, 0.f};
        bf16_t* x1o = WSP(bf16_t, WS_X1) + (size_t)row * DM + 8 * g; unsigned char* x8o = WSP(unsigned char, WS_X1B) + (size_t)row * DM + 8 * g;
        const bf16_t* w0 = RWB + (size_t)rr * 1024 + 8 * g;
#pragma unroll 2
        for (int s = 0; s < 32; ++s) { const int k0 = 32 * s;
            const u32x4 rw_ = *(const u32x4*)(xr + k0); f32x4 a = {bflo(rw_.x), bfhi(rw_.x), bflo(rw_.y), bfhi(rw_.y)}, b = {bflo(rw_.z), bfhi(rw_.z), bflo(rw_.w), bfhi(rw_.w)};
            const f32x4 ga = *(const f32x4*)(g1 + 8 * g + k0), gb = *(const f32x4*)(g1 + 8 * g + k0 + 4), ba = *(const f32x4*)(b1 + 8 * g + k0), bb = *(const f32x4*)(b1 + 8 * g + k0 + 4);
            a = (a - mean) * rstd * ga + ba; b = (b - mean) * rstd * gb + bb;
            { u32x2 w8; w8.x = pk4f8(a[0] * 16.0f, a[1] * 16.0f, a[2] * 16.0f, a[3] * 16.0f); w8.y = pk4f8(b[0] * 16.0f, b[1] * 16.0f, b[2] * 16.0f, b[3] * 16.0f); *(u32x2*)(x8o + k0) = w8; }
            u32x4 hi, lo;
            hi.x = pk2(a[0], a[1]); hi.y = pk2(a[2], a[3]); hi.z = pk2(b[0], b[1]); hi.w = pk2(b[2], b[3]);
            *(u32x4*)(x1o + k0) = hi;
            lo.x = pk2(a[0] - bflo(hi.x), a[1] - bfhi(hi.x)); lo.y = pk2(a[2] - bflo(hi.y), a[3] - bfhi(hi.y)); lo.z = pk2(b[0] - bflo(hi.z), b[1] - bfhi(hi.z)); lo.w = pk2(b[2] - bflo(hi.w), b[3] - bfhi(hi.w));
            const bf16x8 xh = __builtin_bit_cast(bf16x8, hi), xl = __builtin_bit_cast(bf16x8, lo);
            const bf16x8 wh0 = *(const bf16x8*)(w0 + k0), wh1 = *(const bf16x8*)(w0 + 16 * 1024 + k0), wl0 = *(const bf16x8*)(w0 + 32 * 1024 + k0), wl1 = *(const bf16x8*)(w0 + 48 * 1024 + k0);
            acc0 = __builtin_amdgcn_mfma_f32_16x16x32_bf16(xh, wh0, acc0, 0, 0, 0); acc0 = __builtin_amdgcn_mfma_f32_16x16x32_bf16(xl, wh0, acc0, 0, 0, 0); acc0 = __builtin_amdgcn_mfma_f32_16x16x32_bf16(xh, wl0, acc0, 0, 0, 0);
            acc1 = __builtin_amdgcn_mfma_f32_16x16x32_bf16(xh, wh1, acc1, 0, 0, 0); acc1 = __builtin_amdgcn_mfma_f32_16x16x32_bf16(xl, wh1, acc1, 0, 0, 0); acc1 = __builtin_amdgcn_mfma_f32_16x16x32_bf16(xh, wl1, acc1, 0, 0, 0); }
        { const float rb0 = rb[rr], rb1 = rb[16 + rr];
#pragma unroll
          for (int i = 0; i < 4; ++i) { lg[(4 * g + i) * 32 + rr] = acc0[i] + rb0; lg[(4 * g + i) * 32 + 16 + rr] = acc1[i] + rb1; } }
        LDS_WAIT();
        if (lane < 16) { const int row2 = chunk * CHUNK + F.wave * 16 + lane;
            float v0 = -3e38f, v1 = -3e38f, v2 = -3e38f, v3 = -3e38f; int i0 = 0, i1 = 0, i2 = 0, i3 = 0;
            for (int e = 0; e < 32; ++e) { const float x = lg[lane * 32 + e];
                if (x > v0) { v3 = v2; i3 = i2; v2 = v1; i2 = i1; v1 = v0; i1 = i0; v0 = x; i0 = e; }
                else if (x > v1) { v3 = v2; i3 = i2; v2 = v1; i2 = i1; v1 = x; i1 = e; }
                else if (x > v2) { v3 = v2; i3 = i2; v2 = x; i2 = e; }
                else if (x > v3) { v3 = x; i3 = e; } }
            const float e1 = __expf(v1 - v0), e2 = __expf(v2 - v0), e3 = __expf(v3 - v0), inv = 1.0f / (1.0f + e1 + e2 + e3);
            *(int4*)(WSP(int, WS_ROUTE + RT_E) + (size_t)row2 * 4) = make_int4(i0, i1, i2, i3);
            *(f32x4*)(WSP(float, WS_ROUTE + RT_G) + (size_t)row2 * 4) = (f32x4){inv, e1 * inv, e2 * inv, e3 * inv};
            LDS_ADD1(cnt + i0); LDS_ADD1(cnt + i1); LDS_ADD1(cnt + i2); LDS_ADD1(cnt + i3); }
        LDS_WAIT();
        __syncthreads();
        if (F.tid < 32) WSP(int, WS_ROUTE + RT_BLKCNT)[chunk * 32 + F.tid] = cnt[F.tid];
        __syncthreads();
    }
}
DI void phase_route(const Frame& F_) {
    const Frame F = refresh(F_);
    LAS int* pt = (LAS int*)F.lds;
    LAS int* tot = pt + 512;
    LAS int* est = tot + 32;
    LAS int* basel = est + 40;
    LAS int* ea = basel + 32;
    const int* BC = WSP(int, WS_ROUTE + RT_BLKCNT);
    { const int e = F.tid & 31, gq = F.tid >> 5; int s = 0; for (int c = gq * 16; c < gq * 16 + 16; ++c) s += BC[c * 32 + e]; pt[gq * 32 + e] = s; }
    __syncthreads();
    if (F.tid < 32) { int s = 0; for (int q = 0; q < 16; ++q) s += pt[q * 32 + F.tid]; tot[F.tid] = s; }
    __syncthreads();
    if (F.tid == 0) { int s = 0; for (int e = 0; e < 32; ++e) { est[e] = s; s += (tot[e] + 255) & ~255; } est[32] = s; }
    __syncthreads();
    int* SLOT = WSP(int, WS_ROUTE + RT_SLOT);
    if (F.bid == 0) {
        for (int e = 0; e < 32; ++e) { const int s0 = est[e] + tot[e], s1 = est[e + 1]; for (int p = s0 + F.tid; p < s1; p += 512) SLOT[p] = 0;
            for (int t = (est[e] >> 8) + F.tid; t < (est[e + 1] >> 8); t += 512) WSP(int, WS_ROUTE + RT_TILE)[t] = e; }
        if (F.tid == 0) WSP(int, WS_ROUTE + RT_NT)[0] = est[32] >> 8;
    }
    for (int chunk = F.bid; chunk < NCHUNK; chunk += F.G) {
        if (F.tid < 32) { const int e = F.tid, gq = chunk >> 4; int s = est[e]; for (int q = 0; q < gq; ++q) s += pt[q * 32 + e]; for (int c = gq * 16; c < chunk; ++c) s += BC[c * 32 + e]; basel[e] = s; }
        const int a = F.tid, row = chunk * CHUNK + (a >> 2); const int my = WSP(int, WS_ROUTE + RT_E)[(size_t)row * 4 + (a & 3)];
        ea[a] = my;
        __syncthreads();
        int rank = 0; for (int q = 0; q < a; ++q) rank += (ea[q] == my) ? 1 : 0;
        const int pos = basel[my] + rank;
        WSP(int, WS_ROUTE + RT_POS)[(size_t)row * 4 + (a & 3)] = pos; SLOT[pos] = row;
        __syncthreads();
    }
}
DI void phase_combine_ln2(const Frame& F_, int l) {
    const Frame F = refresh(F_);
    const int gw = F.bid * 8 + F.wave, NGW = F.G * 8, lane = F.lane;
    const float* g2 = inp(F, 29) + l * DM; const float* b2 = inp(F, 30) + l * DM; const unsigned char* YB = WSP(unsigned char, WS_YBUF);
    for (int m = gw; m < NTOK; m += NGW) {
        const int4 pos = *(const int4*)(WSP(int, WS_ROUTE + RT_POS) + (size_t)m * 4); const f32x4 gt = *(const f32x4*)(WSP(float, WS_ROUTE + RT_G) + (size_t)m * 4);
        const int pp[4] = {pos.x, pos.y, pos.z, pos.w};
        f32x4 v[4];
#pragma unroll
        for (int j = 0; j < 4; ++j) { const u32x2 xw = *(const u32x2*)(WSP(bf16_t, WS_X1) + (size_t)m * DM + 4 * lane + 256 * j); v[j] = (f32x4){bflo(xw.x), bfhi(xw.x), bflo(xw.y), bfhi(xw.y)} * ALPHA; }
#pragma unroll
        for (int k = 0; k < 4; ++k) { const unsigned char* yr = YB + (size_t)pp[k] * DM + 4 * lane; const float gk = gt[k] * (1.0f / 64.0f);
#pragma unroll
            for (int j = 0; j < 4; ++j) { const int w = *(const int*)(yr + 256 * j); const f32x2 lo = __builtin_amdgcn_cvt_pk_f32_fp8(w, false), hi = __builtin_amdgcn_cvt_pk_f32_fp8(w, true);
                v[j][0] += gk * lo.x; v[j][1] += gk * lo.y; v[j][2] += gk * hi.x; v[j][3] += gk * hi.y; } }
        ln_rowv(v, g2, b2, lane);
        if (l == DEPTH - 1) store_row_f32(F.out + (size_t)m * DM, v, lane);
        else { store_row_bf16(WSP(bf16_t, WS_XB) + (size_t)m * DM, v, lane); store_row_f8(WSP(unsigned char, WS_X8) + (size_t)m * DM, v, lane, 16.0f); }
    }
}

#define IN(k) (lo <= (k) && (k) < hi)
#define GRIDBAR() do { XcdBarrier bar_; bar_.bar = (unsigned*)((unsigned char*)lds_u64(F0.MISC + 60) + WS_CTL) + CW_BAR; bar_.x = xb_xcc_id(); bar_.st = F0.MISC + 8; xcd_barrier(bar_); } while (0)
#define SEAM(k) do { if (IN(k) && IN((k) + 1)) { XcdBarrier bar_; bar_.bar = (unsigned*)((unsigned char*)lds_u64(F0.MISC + 60) + WS_CTL) + CW_BAR; bar_.x = xb_xcc_id(); bar_.st = F0.MISC + 8; xcd_barrier(bar_); } } while (0)
template <int l> DI void ph_gemm_in(const Frame& F0) { const Frame F = refresh(F0);
            { constexpr size_t TS = (size_t)256 * 1024 * 2;
              static_assert(WS_XB % TS == 0 && WS_WIN % TS == 0, "operand tiles");
              pg8::Gemm g{WSP(bf16_t, 0), WSP(bf16_t, 0), 1024, nullptr}; pg8::InOrder S; S.T.init(NTOK / 256, 5, F.G, F.bid); S.G = F.G; S.c = F.bid; S.l = l; S.tA = (int)(WS_XB / TS); S.tW = (int)(WS_WIN / TS);
              pg8::EpiIn E{WSP(bf16_t, WS_PROJ), WSP(bf16_t, WS_ZT), 1.0f};
              pg8::gemm_phase<pg8::EpiIn, pg8::InOrder, false>(F.lds, g, S, E, F.wave); }
            { constexpr size_t TS = (size_t)256 * 1024;
              static_assert(WS_X8 % TS == 0 && WS_WG8 % TS == 0, "operand tiles");
              pg8::Gemm g{WSP(bf16_t, 0), WSP(bf16_t, 0), 1024, nullptr}; pg8::GateOrder S; S.init(NTOK / 256, 12, F.G, F.bid); S.l = l; S.tA = (int)(WS_X8 / TS); S.tW = (int)(WS_WG8 / TS);
              pg8::EpiGL8 E{WSP(unsigned char, WS_ZC), 16.0f / 1024.0f};
              pg8::gemm_phase<pg8::EpiGL8, pg8::GateOrder, true, true>(F.lds, g, S, E, F.wave); }
        }
template <int l> DI void ph_conv_rope(const Frame& F0) { phase_conv_rope(F0, l); }
template <int l> DI void ph_mix(const Frame& F0) {
            const int G = gridDim.x, bid = blockIdx.x;
            if (EN(13)) for (int c = bid; c < 512; c += G) hyena_unit(F0, l, c);
            if (EN(14)) for (int u = bid; u < 512; u += G) swa_unit(F0, l, u);
            if (EN(15)) for (int u = bid; u < 256; u += G) mema_unit(F0, l, u);
            if ((DUP_MASK >> 14) & 1u) { __syncthreads(); for (int u = bid; u < 512; u += G) swa_unit(F0, l, u); }
            if ((DUP_MASK >> 15) & 1u) { __syncthreads(); for (int u = bid; u < 256; u += G) mema_unit(F0, l, u); }
        }
template <int l> DI void ph_tr_y2(const Frame& F0) { phase_tr_y2(F0); }
template <int l> DI void ph_branch(const Frame& F0) { const Frame F = refresh(F0);
            static_assert(WS_YSW == WS_YHY + 32 * MiB && WS_YMEM == WS_YSW + 32 * MiB, "branch activations are three consecutive [NTOK][512] buffers");
            pg8::Gemm g{WSP(bf16_t, WS_YHY), WSP(bf16_t, WS_WBR), 512, nullptr}; pg8::BranchOrder S; S.init(NTOK / 256, 4, F.G, F.bid); S.l = l;
            pg8::EpiGate E{WSP(unsigned char, WS_ZC), inp(F, 5) + (size_t)l * 3 * 1024, WSP(bf16_t, WS_MERGED)};
            pg8::gemm_phase<pg8::EpiGate, pg8::BranchOrder, false>(F.lds, g, S, E, F.wave);
        }
template <int l> DI void ph_out(const Frame& F0) { const Frame F = refresh(F0);
            pg8::Gemm g{WSP(bf16_t, WS_MERGED), WSP(bf16_t, WS_WOUT) + (size_t)l * 1024 * 1024, 1024, nullptr}; pg8::StaticOrder S; S.init(NTOK / 256, 4, F.G, F.bid);
            pg8::EpiRes E{WSP(bf16_t, WS_XB), WSP(bf16_t, WS_R)};
            pg8::gemm_phase<pg8::EpiRes, pg8::StaticOrder, false>(F.lds, g, S, E, F.wave);
        }
template <int l> DI void ph_ln1(const Frame& F0) { phase_ln1_router(F0, l); }
template <int l> DI void ph_route(const Frame& F0) { phase_route(F0); }
template <int l> DI void ph_moe_up(const Frame& F0) { const Frame F = refresh(F0);
            const int ntile = __builtin_amdgcn_readfirstlane(WSP(int, WS_ROUTE + RT_NT)[0]);
            pg8::Gemm g{WSP(bf16_t, WS_X1B), (const bf16_t*)(WSP(unsigned char, WS_W1) + (size_t)l * 32 * 2048 * 1024), 1024, WSP(int, WS_ROUTE + RT_SLOT), F.lds + 131072, inp(F, 26) + (size_t)l * 32 * 2048, 2048};
            { LAS int* lt = (LAS int*)(F.lds + 131072 + 4096); for (int i = F.tid; i < ntile; i += 512) lt[i] = WSP(int, WS_ROUTE + RT_TILE)[i]; __syncthreads(); }
            pg8::GroupOrderL S; S.init(ntile, 8, F.G, F.bid); S.tile_e = (const LAS int*)(F.lds + 131072 + 4096);
            pg8::EpiSwiglu E{WSP(unsigned char, WS_ACT), inp(F, 26) + (size_t)l * 32 * 2048, 1.0f / 1024.0f};
            pg8::gemm_phase<pg8::EpiSwiglu, pg8::GroupOrderL, true, true, true>(F.lds, g, S, E, F.wave);
        }
template <int l> DI void ph_moe_down(const Frame& F0) { const Frame F = refresh(F0);
            const int ntile = __builtin_amdgcn_readfirstlane(WSP(int, WS_ROUTE + RT_NT)[0]);
            pg8::Gemm g{WSP(bf16_t, WS_ACT), (const bf16_t*)(WSP(unsigned char, WS_W2) + (size_t)l * 32 * 1024 * 1024), 1024, WSP(int, WS_ROUTE + RT_IOTA), F.lds + 131072, inp(F, 28) + (size_t)l * 32 * 1024, 1024};
            { LAS int* lt = (LAS int*)(F.lds + 131072 + 4096); for (int i = F.tid; i < ntile; i += 512) lt[i] = WSP(int, WS_ROUTE + RT_TILE)[i]; __syncthreads(); }
            pg8::GroupOrderL S; S.init(ntile, 4, F.G, F.bid); S.tile_e = (const LAS int*)(F.lds + 131072 + 4096);
            pg8::EpiBf16 E{WSP(bf16_t, WS_YBUF), DM, 0, inp(F, 28) + (size_t)l * 32 * 1024, 1024, 1.0f / 1024.0f, 1};
            pg8::gemm_phase<pg8::EpiBf16, pg8::GroupOrderL, true, true, true>(F.lds, g, S, E, F.wave);
        }
template <int l> DI void ph_ln2(const Frame& F0) { phase_combine_ln2(F0, l); }
template <int l> DI void layer_body(const Frame& F0, const int lo, const int hi) {
        constexpr int pb = 2 + l * NPH_LAYER;
        if (EN(2) && IN(pb + 0)) { ph_gemm_in<l>(F0); if ((DUP_MASK >> 2) & 1u) { GRIDBAR(); ph_gemm_in<l>(F0); } }
        SEAM(pb + 0);
        if (EN(4) && IN(pb + 2)) { ph_mix<l>(F0); if ((DUP_MASK >> 4) & 1u) { GRIDBAR(); ph_mix<l>(F0); } }
        SEAM(pb + 2);
        if (EN(5) && IN(pb + 3)) { ph_tr_y2<l>(F0); if ((DUP_MASK >> 5) & 1u) { GRIDBAR(); ph_tr_y2<l>(F0); } }
        SEAM(pb + 3);
        if (EN(6) && IN(pb + 4)) { ph_branch<l>(F0); if ((DUP_MASK >> 6) & 1u) { GRIDBAR(); ph_branch<l>(F0); } }
        SEAM(pb + 4);
        if (EN(7) && IN(pb + 5)) { ph_out<l>(F0); if ((DUP_MASK >> 7) & 1u) { GRIDBAR(); ph_out<l>(F0); } }
        SEAM(pb + 5);
        if (EN(8) && IN(pb + 6)) { ph_ln1<l>(F0); if ((DUP_MASK >> 8) & 1u) { GRIDBAR(); ph_ln1<l>(F0); } }
        SEAM(pb + 6);
        if (EN(9) && IN(pb + 7)) { ph_route<l>(F0); if ((DUP_MASK >> 9) & 1u) { GRIDBAR(); ph_route<l>(F0); } }
        SEAM(pb + 7);
        if (EN(10) && IN(pb + 8)) { ph_moe_up<l>(F0); if ((DUP_MASK >> 10) & 1u) { GRIDBAR(); ph_moe_up<l>(F0); } }
        SEAM(pb + 8);
        if (EN(11) && IN(pb + 9)) { ph_moe_down<l>(F0); if ((DUP_MASK >> 11) & 1u) { GRIDBAR(); ph_moe_down<l>(F0); } }
        SEAM(pb + 9);
        if (EN(12) && IN(pb + 10)) { ph_ln2<l>(F0); if ((DUP_MASK >> 12) & 1u) { GRIDBAR(); ph_ln2<l>(F0); } }
        SEAM(pb + 10);
    }
struct Args { const float* in[31]; float* out; unsigned char* ws; int ph_lo, ph_hi; };
__global__ void __launch_bounds__(512, 2) mega_fwd(Args args) {
    extern __shared__ __attribute__((aligned(16))) unsigned char lds_raw[];
    Frame F0;
#define F F0
    F.lds = (LAS unsigned char*)lds_raw; F.MISC = (volatile LAS unsigned*)(F.lds + MISC_OFF);
    F.tid = threadIdx.x; F.lane = F.tid & 63; F.wave = __builtin_amdgcn_readfirstlane(F.tid >> 6); F.G = gridDim.x; F.bid = blockIdx.x;
    F.out = args.out; F.ws = args.ws;
    if (F.tid < 60) F.MISC[F.tid] = 0u;
    if (F.tid == 65) { const unsigned long long w = (unsigned long long)args.ws, o = (unsigned long long)args.out; F.MISC[60] = (unsigned)w; F.MISC[61] = (unsigned)(w >> 32); F.MISC[62] = (unsigned)o; F.MISC[63] = (unsigned)(o >> 32); }
    if (F.tid == 64) {
#pragma unroll
        for (int i = 0; i < 31; ++i) { const unsigned long long p = (unsigned long long)args.in[i]; F.MISC[64 + 2 * i] = (unsigned)p; F.MISC[64 + 2 * i + 1] = (unsigned)(p >> 32); } }
    __syncthreads();
    if (!MK_PER_PHASE) (void)xcd_barrier_post(WSP(unsigned, WS_CTL) + CW_BAR, F.MISC + 8);
#undef F
    const int lo = args.ph_lo, hi = args.ph_hi;
    F0.out = nullptr; F0.ws = nullptr; F0.tid = 0; F0.lane = 0;

    if (EN(0) && IN(0)) REP(0) { REPBAR(); phase_proA(F0); }
    SEAM(0);
    if (EN(1) && IN(1)) REP(1) { REPBAR(); const Frame F = refresh(F0);
        if (EN(19)) { pg8::Gemm g{WSP(bf16_t, WS_FW), WSP(bf16_t, WS_FH), 256, nullptr}; pg8::BatchOrder S{4, 8, 64, 8, 0, 64, 0, F.G, F.bid}; pg8::EpiWin E{WSP(_Float16, WS_HF)};
          pg8::gemm_phase<pg8::EpiWin, pg8::BatchOrder, false>(F.lds, g, S, E, F.wave); }
        if (EN(20)) { pg8::Gemm g{WSP(bf16_t, WS_MEMB), WSP(bf16_t, WS_WKV), 1024, nullptr}; pg8::BatchOrder S{4, 2, 2, 0, 0, 4, 0, F.G, F.bid}; pg8::EpiBf16 E{WSP(bf16_t, WS_MK), 512, (size_t)512 * 512, nullptr, 0};
          pg8::gemm_phase<pg8::EpiBf16, pg8::BatchOrder, false>(F.lds, g, S, E, F.wave); }
        if (EN(21)) { pg8::Gemm g{WSP(bf16_t, WS_WKV), WSP(bf16_t, WS_MEMB), 1024, nullptr}; pg8::BatchOrder S{4, 2, 2, 4, 2, 0, 0, F.G, F.bid}; pg8::EpiBf16 E{WSP(bf16_t, WS_MVT), 512, (size_t)512 * 512, nullptr, 0};
          pg8::gemm_phase<pg8::EpiBf16, pg8::BatchOrder, false>(F.lds, g, S, E, F.wave); }
    }
    SEAM(1);
    layer_body<0>(F0, lo, hi); layer_body<1>(F0, lo, hi); layer_body<2>(F0, lo, hi); layer_body<3>(F0, lo, hi);
#undef IN
#undef SEAM
}

extern "C" void kernel_launch(void* const* d_in, const int* in_sizes, int n_in, void* d_out, int out_size, void* d_ws, size_t ws_size, hipStream_t stream) {
    static int grid = 0;
    if (grid == 0) {
        if (n_in != 31 || out_size != NTOK * DM || ws_size < WS_END) { fprintf(stderr, "kernel_launch: unexpected shapes (n_in %d out %d ws %zu)\n", n_in, out_size, ws_size); grid = -1; return; }
        int dev = 0, cus = 0, per_cu = 0;
        if (hipGetDevice(&dev) != hipSuccess || hipDeviceGetAttribute(&cus, hipDeviceAttributeMultiprocessorCount, dev) != hipSuccess) { grid = -1; return; }
        if (hipFuncSetAttribute((const void*)mega_fwd, hipFuncAttributeMaxDynamicSharedMemorySize, LDS_BYTES) != hipSuccess) { fprintf(stderr, "kernel_launch: hipFuncSetAttribute failed\n"); grid = -1; return; }
        if (hipOccupancyMaxActiveBlocksPerMultiprocessor(&per_cu, (const void*)mega_fwd, 512, LDS_BYTES) != hipSuccess || per_cu < 1) { fprintf(stderr, "kernel_launch: occupancy query says %d\n", per_cu); }
        (void)hipGetLastError();
        grid = cus < 256 ? cus : 256;
    }
    if (grid < 0) return;
    (void)hipMemsetAsync((char*)d_ws + WS_CTL, 0, CTL_ZERO_BYTES, stream);
    Args a{};
    for (int i = 0; i < 31; ++i) a.in[i] = (const float*)d_in[i];
    a.out = (float*)d_out; a.ws = (unsigned char*)d_ws;
#if MK_PER_PHASE
    for (int p = 0; p < NPHASES; ++p) { a.ph_lo = p; a.ph_hi = p + 1; hipLaunchKernelGGL(mega_fwd, dim3(grid), dim3(512), LDS_BYTES, stream, a); }
#else
    a.ph_lo = 0; a.ph_hi = NPHASES;
    hipLaunchKernelGGL(mega_fwd, dim3(grid), dim3(512), LDS_BYTES, stream, a);
#endif
}
```
